# Optimizing an MI355X kernel written in HIP

```python
import jax
import jax.numpy as jnp
from jax import lax
import numpy as np

D_MODEL = 2048
BATCH = 1
SEQ = 16384
DEPTH = 2
DEC_BATCH = 32
DEC_SEQ = 32
PAST_LEN = 1024

CHUNK = 64
D_HGRN = D_MODEL // 2
HGRN_HEADS = 8
HGRN_DK = D_HGRN // HGRN_HEADS
HGRN_DV = D_HGRN // HGRN_HEADS
D_S5 = D_MODEL // 2
S5_GROUP = 16
S5_GROUPS = D_S5 // S5_GROUP
S5_STATE = 64
D_FF = -(-8 * D_MODEL // (3 * 256)) * 256
IN_COLS = 4 * D_HGRN + D_S5 + 2 * D_MODEL
SPLITS = (D_HGRN, 2 * D_HGRN, 3 * D_HGRN, 4 * D_HGRN, 4 * D_HGRN + D_S5, 4 * D_HGRN + D_S5 + D_MODEL)
EPS = 1e-6
DT_MIN = 1e-3
DT_MAX = 1e-1

kernel_name = 'hgrn2_s5_gated_hybrid_step'


def rmsnorm(x, w):
    xf = x.astype(jnp.float32)
    xf = xf * lax.rsqrt(jnp.mean(xf * xf, axis=-1, keepdims=True) + EPS)
    return (xf * w.astype(jnp.float32)).astype(x.dtype)


def hgrn_lower_bounds(lb_logits):
    p = jax.nn.softmax(lb_logits.astype(jnp.float32), axis=0)
    cs = jnp.cumsum(p, axis=0)
    return cs - cs[:1]


def hgrn2_chunk(q, k, v, logf, s0):
    c = q.shape[1]
    b = jnp.cumsum(logf, axis=1)
    o_inter = jnp.einsum('bthk,bhkv->bthv', q * jnp.exp(b), s0)
    causal = jnp.tril(jnp.ones((c, c), dtype=bool))
    diff = b[:, :, None] - b[:, None, :]
    decay = jnp.exp(jnp.where(causal[None, :, :, None, None], diff, -jnp.inf))
    scores = jnp.einsum('bthk,bshk,btshk->btsh', q, k, decay)
    o = o_inter + jnp.einsum('btsh,bshv->bthv', scores, v)
    b_last = b[:, -1]
    s_new = jnp.exp(b_last)[..., None] * s0 + jnp.einsum('bshk,bshv->bhkv', k * jnp.exp(b_last[:, None] - b), v)
    return o, s_new


def hgrn2_recurrence(q, k, v, logf, s0):
    bsz, t = q.shape[0], q.shape[1]
    if t <= CHUNK:
        return hgrn2_chunk(q, k, v, logf, s0)
    n = t // CHUNK

    def to_blocks(a):
        return jnp.moveaxis(a.reshape((bsz, n, CHUNK) + a.shape[2:]), 1, 0)

    def step(s, xs):
        qc, kc, vc, fc = xs
        o, s = hgrn2_chunk(qc, kc, vc, fc, s)
        return s, o

    s_fin, o = lax.scan(step, s0, (to_blocks(q), to_blocks(k), to_blocks(v), to_blocks(logf)))
    o = jnp.moveaxis(o, 0, 1).reshape((bsz, t) + o.shape[3:])
    return o, s_fin


def hgrn2_branch(q_lin, f_lin, i_lin, g_lin, lb, gain, s0):
    f32 = jnp.float32
    bsz, t, _ = q_lin.shape
    shp_k = (bsz, t, HGRN_HEADS, HGRN_DK)
    shp_v = (bsz, t, HGRN_HEADS, HGRN_DV)
    z = f_lin.astype(f32)
    logf = jnp.logaddexp(jnp.log(lb), jnp.log1p(-lb) + jax.nn.log_sigmoid(z))
    k = (1.0 - lb) * jax.nn.sigmoid(-z)
    q = q_lin.astype(f32).reshape(shp_k)
    v = jax.nn.silu(i_lin.astype(f32)).reshape(shp_v)
    o, s_new = hgrn2_recurrence(q, k.reshape(shp_k), v, logf.reshape(shp_k), s0.astype(f32))
    o = o * lax.rsqrt(jnp.mean(o * o, axis=-1, keepdims=True) + EPS)
    o = o.reshape(bsz, t, D_HGRN) * gain.astype(f32) * jax.nn.silu(g_lin.astype(f32))
    return o.astype(q_lin.dtype), s_new


def _linear_combine(left, right):
    a_l, b_l = left
    a_r, b_r = right
    return (a_r * a_l, a_r * b_l + b_r)


def s5_branch(u, s_re0, s_im0, a_log_neg_re, a_im, log_dt, b_re, b_im, c_re, c_im, d_skip, w_glu, b_glu):
    f32 = jnp.float32
    bsz, t, _ = u.shape
    uf = u.astype(f32)
    ug = uf.reshape(bsz, t, S5_GROUPS, S5_GROUP)
    lam = lax.complex(-jnp.exp(a_log_neg_re.astype(f32)), a_im.astype(f32))
    dt = jnp.exp(log_dt.astype(f32))[:, None]
    lam_bar = jnp.exp(lam * dt)
    zoh = (lam_bar - 1.0) / lam
    b_bar = zoh[..., None] * lax.complex(b_re.astype(f32), b_im.astype(f32))
    bu = lax.complex(jnp.einsum('gnp,btgp->btgn', b_bar.real, ug),
                     jnp.einsum('gnp,btgp->btgn', b_bar.imag, ug))
    s0 = lax.complex(s_re0.astype(f32), s_im0.astype(f32))
    bu = bu.at[:, 0].add(lam_bar * s0)
    a = jnp.broadcast_to(lam_bar, bu.shape)
    _, xs = lax.associative_scan(_linear_combine, (a, bu), axis=1)
    y = (jnp.einsum('gpn,btgn->btgp', c_re.astype(f32), xs.real)
         - jnp.einsum('gpn,btgn->btgp', c_im.astype(f32), xs.imag))
    y = y.reshape(bsz, t, D_S5) + d_skip.astype(f32) * uf
    y = jax.nn.gelu(y)
    y = y * jax.nn.sigmoid(y @ w_glu.astype(f32) + b_glu.astype(f32))
    s_last = xs[:, -1]
    return y.astype(u.dtype), jnp.real(s_last), jnp.imag(s_last)


def layer(x, s_h, s_re, s_im, lb, norm1, w_in, hgrn_norm, w_bh, a_log_neg_re, a_im, log_dt,
          b_re, b_im, c_re, c_im, d_skip, w_glu, b_glu, w_bs, w_out, norm2, w_gate_up, w_down):
    h = rmsnorm(x, norm1)
    q, f, i, g, u, gh, gs = jnp.split(h @ w_in, SPLITS, axis=-1)
    o_h, s_h_new = hgrn2_branch(q, f, i, g, lb, hgrn_norm, s_h)
    o_s, s_re_new, s_im_new = s5_branch(u, s_re, s_im, a_log_neg_re, a_im, log_dt, b_re, b_im,
                                        c_re, c_im, d_skip, w_glu, b_glu)
    mix = jax.nn.sigmoid(gh) * (o_h @ w_bh) + jax.nn.sigmoid(gs) * (o_s @ w_bs)
    x = x + mix @ w_out
    ga, up = jnp.split(rmsnorm(x, norm2) @ w_gate_up, 2, axis=-1)
    x = x + (jax.nn.silu(ga) * up) @ w_down
    return x, s_h_new, s_re_new, s_im_new


def setup_inputs(seed: int = 0) -> dict:
    key = jax.random.key(seed)
    ks = jax.random.split(key, 26)
    f32 = jnp.float32

    def nrm(k, shape, scale):
        return jax.random.normal(k, shape, f32) * scale

    L, D, G, N, P = DEPTH, D_MODEL, S5_GROUPS, S5_STATE, S5_GROUP
    n_idx = jnp.arange(N, dtype=f32)
    return {
        'x_prompt': nrm(ks[0], (BATCH, SEQ, D), 1.0),
        'x_sample': nrm(ks[1], (DEC_BATCH, DEC_SEQ, D), 1.0),
        'state_hgrn': nrm(ks[2], (L, DEC_BATCH, HGRN_HEADS, HGRN_DK, HGRN_DV), 0.5),
        'state_s5_re': nrm(ks[3], (L, DEC_BATCH, G, N), 0.1),
        'state_s5_im': nrm(ks[4], (L, DEC_BATCH, G, N), 0.1),
        'lb_logits': nrm(ks[5], (L, D_HGRN), 0.5),
        'norm1': 1.0 + nrm(ks[6], (L, D), 0.02),
        'w_in': nrm(ks[7], (L, D, IN_COLS), D ** -0.5),
        'hgrn_norm': 1.0 + nrm(ks[8], (L, D_HGRN), 0.02),
        'w_bh': nrm(ks[9], (L, D_HGRN, D), D_HGRN ** -0.5),
        's5_a_log_neg_re': np.float32(np.log(0.5)) + nrm(ks[10], (L, G, N), 0.02),
        's5_a_im': np.float32(np.pi) * n_idx + nrm(ks[11], (L, G, N), 0.02),
        's5_log_dt': jax.random.uniform(ks[12], (L, G), f32, float(np.log(DT_MIN)), float(np.log(DT_MAX))),
        's5_b_re': nrm(ks[13], (L, G, N, P), (2 * P) ** -0.5),
        's5_b_im': nrm(ks[14], (L, G, N, P), (2 * P) ** -0.5),
        's5_c_re': nrm(ks[15], (L, G, P, N), 0.5),
        's5_c_im': nrm(ks[16], (L, G, P, N), 0.5),
        's5_d': nrm(ks[17], (L, D_S5), 1.0),
        'w_glu': nrm(ks[18], (L, D_S5, D_S5), D_S5 ** -0.5),
        'b_glu': nrm(ks[19], (L, D_S5), 0.02),
        'w_bs': nrm(ks[20], (L, D_S5, D), D_S5 ** -0.5),
        'w_out': nrm(ks[21], (L, D, D), D ** -0.5),
        'norm2': 1.0 + nrm(ks[22], (L, D), 0.02),
        'w_gate_up': nrm(ks[23], (L, D, 2 * D_FF), D ** -0.5),
        'w_down': nrm(ks[24], (L, D_FF, D), D_FF ** -0.5),
        'final_norm': 1.0 + nrm(ks[25], (D,), 0.02),
    }


def reference(x_prompt, x_sample, state_hgrn, state_s5_re, state_s5_im, lb_logits, norm1, w_in,
              hgrn_norm, w_bh, s5_a_log_neg_re, s5_a_im, s5_log_dt, s5_b_re, s5_b_im, s5_c_re, s5_c_im,
              s5_d, w_glu, b_glu, w_bs, w_out, norm2, w_gate_up, w_down, final_norm):
    f32 = jnp.float32
    lbs = hgrn_lower_bounds(lb_logits)

    def trunk(x, s_h, s_re, s_im):
        new_h, new_re, new_im = [], [], []
        for l in range(DEPTH):
            x, sh_l, sre_l, sim_l = layer(
                x, s_h[l], s_re[l], s_im[l], lbs[l], norm1[l], w_in[l], hgrn_norm[l], w_bh[l],
                s5_a_log_neg_re[l], s5_a_im[l], s5_log_dt[l], s5_b_re[l], s5_b_im[l], s5_c_re[l],
                s5_c_im[l], s5_d[l], w_glu[l], b_glu[l], w_bs[l], w_out[l], norm2[l], w_gate_up[l], w_down[l])
            new_h.append(sh_l)
            new_re.append(sre_l)
            new_im.append(sim_l)
        return rmsnorm(x, final_norm), jnp.stack(new_h), jnp.stack(new_re), jnp.stack(new_im)

    bp = x_prompt.shape[0]
    zero_h = jnp.zeros((DEPTH, bp, HGRN_HEADS, HGRN_DK, HGRN_DV), f32)
    zero_s = jnp.zeros((DEPTH, bp, S5_GROUPS, S5_STATE), f32)
    y_prompt, hgrn_p, s5_re_p, s5_im_p = trunk(x_prompt, zero_h, zero_s, zero_s)
    y_sample, hgrn_s, s5_re_s, s5_im_s = trunk(x_sample, state_hgrn, state_s5_re, state_s5_im)
    return (y_prompt, y_sample, hgrn_p, s5_re_p, s5_im_p, hgrn_s, s5_re_s, s5_im_s)
```

```cpp
#include <hip/hip_runtime.h>
#include <hip/hip_cooperative_groups.h>
#include <cstdio>
namespace cg = cooperative_groups;

#ifndef COOP
#define COOP 1
#endif

#define LAS __attribute__((address_space(3)))
#define DI __device__ __forceinline__
typedef unsigned short bf16_t;
typedef short bf16x8 __attribute__((ext_vector_type(8)));
typedef short bf16x4 __attribute__((ext_vector_type(4)));
typedef float f32x4 __attribute__((ext_vector_type(4)));
typedef float f32x2 __attribute__((ext_vector_type(2)));
typedef unsigned u32x4 __attribute__((ext_vector_type(4)));
typedef unsigned u32x2 __attribute__((ext_vector_type(2)));
typedef __bf16 bfv2 __attribute__((ext_vector_type(2)));

constexpr int TP = 16384, TS = 1024, T = TP + TS, DM = 2048, DH = 1024, NHEAD = 8, NG = 64, DFF = 5632, INC = 9216;
constexpr int C_Q = 0, C_I = 2048, C_G = 3072, C_U = 4096, C_GH = 5120, C_GS = 7168;
constexpr int HSEG = 512, NHSEG = TP / HSEG;
constexpr int SSEG = 256, NSSEG = TP / SSEG;
constexpr size_t O_Y = 0, O_HP = (size_t)T * DM, O_SRP = O_HP + 262144, O_SIP = O_SRP + 8192, O_HS = O_SIP + 8192, O_SRS = O_HS + 8388608, O_SIS = O_SRS + 262144;
constexpr size_t WS_WIN = 0, WS_WGLU = WS_WIN + (size_t)INC * DM * 2, WS_WBH = WS_WGLU + (size_t)DH * DH * 2, WS_WBS = WS_WBH + (size_t)DM * DH * 2,
                 WS_WOUT = WS_WBS + (size_t)DM * DH * 2, WS_WGU = WS_WOUT + (size_t)DM * DM * 2, WS_WDN = WS_WGU + (size_t)2 * DFF * DM * 2,
                 WS_HB = WS_WDN + (size_t)DM * DFF * 2, WS_OH = WS_HB, WS_YS = WS_HB + (size_t)T * DH * 2,
                 WS_P = WS_HB + (size_t)T * DM * 2, WS_HID = WS_P,
                 WS_FZ = WS_P + (size_t)T * INC * 2, WS_MIX = WS_FZ,
                 WS_OS = WS_FZ + (size_t)T * DH * 4,
                 WS_SEG = WS_OS + (size_t)T * DH * 2, WS_DSEG = WS_SEG + (size_t)NHSEG * 8 * 16384 * 4,
                 WS_S5E = WS_DSEG + (size_t)NHSEG * 8 * 128 * 4,
                 WS_LAMB = WS_S5E + (size_t)NSSEG * 64 * 128 * 4, WS_LAML = WS_LAMB + 64 * 128 * 4, WS_BMT = WS_LAML + 64 * 128 * 4, WS_CMT = WS_BMT + 64 * 128 * 16 * 2,
                 WS_BAR = WS_CMT + 64 * 16 * 128 * 2, WS_PART = WS_BAR + 4096, WS_END = WS_PART + (size_t)32 * 8 * 65536 * 4;
constexpr int LDS_BYTES = 131072;
constexpr int NPH_LAYER = 11, NPHASES = 2 * NPH_LAYER + 1;

struct Params { const float* in[26]; float* out; unsigned char* ws; };
struct Ctx { int tid, bid, nb; };

DI float bf2f(bf16_t b) { return __uint_as_float(((unsigned)b) << 16); }
DI unsigned pk2(float lo, float hi) { f32x2 v = {lo, hi}; bfv2 b = __builtin_convertvector(v, bfv2); return __builtin_bit_cast(unsigned, b); }
DI bf16_t f2bf(float f) { return (bf16_t)(pk2(f, 0.f) & 0xffffu); }
DI float sigmoidf_(float v) { return __builtin_amdgcn_rcpf(1.0f + __expf(-v)); }
DI float wave_sum(float v) {
#pragma unroll
    for (int o = 1; o < 64; o <<= 1) v += __shfl_xor(v, o);
    return v;
}
DI void lds_fence() { asm volatile("s_waitcnt lgkmcnt(0)" ::: "memory"); }
DI size_t blk(size_t row, int col, int ncols) { return ((row >> 8) * (size_t)(ncols >> 6) + (size_t)(col >> 6)) * 16384 + (row & 255) * 64 + (col & 63); }
DI void lds_barrier() { asm volatile("s_waitcnt lgkmcnt(0)" ::: "memory"); __builtin_amdgcn_s_barrier(); asm volatile("" ::: "memory"); }
DI bf16x8 mk8(bf16x4 a, bf16x4 b) { bf16x8 r; r[0] = a[0]; r[1] = a[1]; r[2] = a[2]; r[3] = a[3]; r[4] = b[0]; r[5] = b[1]; r[6] = b[2]; r[7] = b[3]; return r; }
DI bf16x8 mk8u(unsigned a, unsigned b, unsigned c, unsigned d) { u32x4 v = {a, b, c, d}; return __builtin_bit_cast(bf16x8, v); }
#define MFMA16(a, b, c) __builtin_amdgcn_mfma_f32_16x16x32_bf16((a), (b), (c), 0, 0, 0)

namespace pg8 {
constexpr int BM = 256, BK = 64, HALF = 128, HTB = HALF * BK * 2, STAGE_BYTES = 8 * HTB, NXCD = 8, WGM = 8;
DI int lds_byte(int r, int c) { const int st = (r >> 4) * 2 + (c >> 5), rr = r & 15, cc = c & 31, ob = rr * 64 + cc * 2; return st * 1024 + (ob ^ (((ob >> 9) & 1) << 5)); }
DI void stage_rc(int b, int& R, int& C) { const int st = b / 1024, sb = b % 1024, swz = sb ^ (((sb >> 9) & 1) << 5); R = (st >> 1) * 16 + swz / 64; C = (st & 1) * 32 + (swz % 64) / 2; }
DI int perm32(int rho) { const int n = rho >> 4, i = rho & 15; return 8 * (i >> 2) + 4 * n + (i & 3); }
struct Unit { int pm, pn, kt0, ntk, kp, slot; };
struct Gemm { const bf16_t* A; const bf16_t* Bt; int M, N, K; };
DI void map_unit(int wgid, int nM, int nN, int nwg, int& pm, int& pn) {
    { const int q = nwg / NXCD, r = nwg % NXCD, xcd = wgid % NXCD, off = wgid / NXCD; wgid = (xcd < r ? xcd * (q + 1) : r * (q + 1) + (xcd - r) * q) + off; }
    const int nig = WGM * nN, gid = wgid / nig, fm = gid * WGM, gsz = (nM - fm) < WGM ? (nM - fm) : WGM;
    pm = fm + ((wgid % nig) % gsz); pn = (wgid % nig) / gsz;
}
struct StaticOrder {
    int nM, nN, nwg, G, c, nt, nsplit, nfull;
    DI void init(int M, int N, int K, int G_, int c_, int nsplit_) { nM = M / BM; nN = N / BM; nwg = nM * nN; G = G_; c = c_; nt = K / BK; nsplit = nsplit_; nfull = nsplit_ ? (nwg / G_) * G_ : nwg; }
    DI bool next(int i, Unit& u) const {
        const long L = (long)i * G + c; int uidx;
        if (L < nfull) { uidx = (int)L; u.kp = -1; u.slot = 0; u.kt0 = 0; u.ntk = nt; }
        else { const long q = L - nfull; if (q >= (long)(nwg - nfull) * nsplit) return false;
            u.slot = (int)(q / nsplit); u.kp = (int)(q % nsplit); uidx = nfull + u.slot;
            const int base = (nt / nsplit) & ~1, half_extra = (nt - base * nsplit) >> 1;
            u.ntk = base + (u.kp < half_extra ? 2 : 0); u.kt0 = u.kp * base + 2 * (u.kp < half_extra ? u.kp : half_extra); }
        map_unit(uidx, nM, nN, nwg, u.pm, u.pn); return true;
    }
};
template <class Epi>
DI void gemm_phase(const Ctx cx, LAS unsigned char* lds, const Gemm g, const StaticOrder& S, const Epi& E) {
    const int tid = cx.tid, wid = __builtin_amdgcn_readfirstlane(tid >> 6), lane = tid & 63, wr = wid >> 2, wc = wid & 3, fr = lane & 15, fq = lane >> 4;
    const int K = g.K;
    unsigned voffA[2], voffB[2];
#pragma unroll
    for (int i = 0; i < 2; ++i) { int R, C; stage_rc(tid * 16 + i * 8192, R, C); const int Rb = Epi::PERM ? ((R & ~31) + perm32(R & 31)) : R;
        voffA[i] = (unsigned)(R * BK + C) * 2u; voffB[i] = (unsigned)(Rb * BK + C) * 2u; }
    const size_t kstep = (size_t)BM * BK * 2;
    const size_t hstep = (size_t)HALF * BK * 2;
    const size_t tstep = (size_t)(K / BK) * kstep;
    const unsigned ldsw = (unsigned)wid * 1024u;
    const int aoff = lds_byte(wr * 64 + fr, fq * 8), boff = lds_byte(wc * 32 + fr, fq * 8);
#define PG8_SA(b, h) (((b) * 2 + (h)) * HTB)
#define PG8_SB(b, h) ((4 + (b) * 2 + (h)) * HTB)
#define PG8_STAGE(bufoff, gbase, voff) do { _Pragma("unroll") for (int _i = 0; _i < 2; ++_i) \
        __builtin_amdgcn_global_load_lds((const unsigned*)((const char*)(gbase) + (voff)[_i]), (LAS unsigned*)(lds + (bufoff) + ldsw + _i * 8192), 16, 0, 0); } while (0)
#define PG8_LDA(dst, b, h) do { _Pragma("unroll") for (int m = 0; m < 4; ++m) _Pragma("unroll") for (int k = 0; k < 2; ++k) dst[m][k] = *(const LAS bf16x8*)(lds + PG8_SA(b, h) + aoff + m * 2048 + k * 1024); } while (0)
#define PG8_LDB(dst, b, h) do { _Pragma("unroll") for (int n = 0; n < 2; ++n) _Pragma("unroll") for (int k = 0; k < 2; ++k) dst[n][k] = *(const LAS bf16x8*)(lds + PG8_SB(b, h) + boff + n * 2048 + k * 1024); } while (0)
#define PG8_MMA(ai, bj, At, Bt) do { __builtin_amdgcn_s_setprio(1); _Pragma("unroll") for (int m = 0; m < 4; ++m) _Pragma("unroll") for (int n = 0; n < 2; ++n) _Pragma("unroll") for (int k = 0; k < 2; ++k) \
        acc[ai][bj][m][n] = __builtin_amdgcn_mfma_f32_16x16x32_bf16(Bt[n][k], At[m][k], acc[ai][bj][m][n], 0, 0, 0); __builtin_amdgcn_s_setprio(0); } while (0)
#define PG8_WAIT_V(n) asm volatile("s_waitcnt vmcnt(" #n ")" ::: "memory")
#define PG8_WAIT_L(n) asm volatile("s_waitcnt lgkmcnt(" #n ")" ::: "memory")
#define PG8_BAR __builtin_amdgcn_s_barrier()
#define PG8_SCHED __builtin_amdgcn_sched_barrier(0)
    Unit cur, nxt; int ui = 0;
    if (!S.next(0, cur)) return;
    f32x4 acc[2][2][4][2];
#pragma unroll
    for (int a = 0; a < 2; ++a)
#pragma unroll
        for (int b = 0; b < 2; ++b)
#pragma unroll
            for (int m = 0; m < 4; ++m)
#pragma unroll
                for (int n = 0; n < 2; ++n) acc[a][b][m][n] = (f32x4){0.f, 0.f, 0.f, 0.f};
    bf16x8 At[4][2], B0[2][2], B1[2][2];
    const char* cA = (const char*)g.A + (size_t)cur.pm * tstep + (size_t)cur.kt0 * kstep; const char* cB = (const char*)g.Bt + (size_t)cur.pn * tstep + (size_t)cur.kt0 * kstep;
    PG8_STAGE(PG8_SB(0, 0), cB, voffB); PG8_STAGE(PG8_SA(0, 0), cA, voffA); PG8_STAGE(PG8_SB(0, 1), cB + hstep, voffB); PG8_STAGE(PG8_SA(0, 1), cA + hstep, voffA);
    if (wr == 1) PG8_BAR;
    PG8_WAIT_V(4); PG8_BAR;
    PG8_STAGE(PG8_SB(1, 0), cB + kstep, voffB); PG8_STAGE(PG8_SA(1, 0), cA + kstep, voffA); PG8_STAGE(PG8_SB(1, 1), cB + hstep + kstep, voffB);
    PG8_WAIT_V(6); PG8_BAR;
    for (;;) {
        const bool has_next = S.next(ui + 1, nxt);
        const char* nA = has_next ? (const char*)g.A + (size_t)nxt.pm * tstep + (size_t)nxt.kt0 * kstep : cA; const char* nB = has_next ? (const char*)g.Bt + (size_t)nxt.pn * tstep + (size_t)nxt.kt0 * kstep : cB;
        const int nt = cur.ntk;
        for (int t = 0; t < nt; t += 2) {
            const bool last = (t == nt - 2);
            const char* a1 = cA + (size_t)(t + 1) * kstep;
            const char* a2 = last ? nA : cA + (size_t)(t + 2) * kstep; const char* b2 = last ? nB : cB + (size_t)(t + 2) * kstep;
            const char* a3 = a2 + kstep; const char* b3 = b2 + kstep;
            PG8_LDB(B0, 0, 0); PG8_SCHED; PG8_LDA(At, 0, 0); PG8_STAGE(PG8_SA(1, 1), a1 + hstep, voffA);
            PG8_WAIT_L(8); PG8_BAR; PG8_WAIT_L(0); PG8_MMA(0, 0, At, B0); PG8_BAR; PG8_SCHED;
            PG8_LDB(B1, 0, 1); PG8_STAGE(PG8_SB(0, 0), b2, voffB);
            PG8_BAR; PG8_WAIT_L(0); PG8_MMA(0, 1, At, B1); PG8_BAR;
            PG8_LDA(At, 0, 1); PG8_STAGE(PG8_SA(0, 0), a2, voffA);
            PG8_BAR; PG8_WAIT_L(0); PG8_MMA(1, 0, At, B0); PG8_BAR; PG8_SCHED;
            PG8_STAGE(PG8_SB(0, 1), b2 + hstep, voffB);
            PG8_WAIT_V(6); PG8_BAR; PG8_MMA(1, 1, At, B1); PG8_BAR;
            PG8_LDB(B0, 1, 0); PG8_SCHED; PG8_LDA(At, 1, 0); PG8_STAGE(PG8_SA(0, 1), a2 + hstep, voffA);
            PG8_WAIT_L(8); PG8_BAR; PG8_WAIT_L(0); PG8_MMA(0, 0, At, B0); PG8_BAR; PG8_SCHED;
            PG8_LDB(B1, 1, 1); PG8_STAGE(PG8_SB(1, 0), b3, voffB);
            PG8_BAR; PG8_WAIT_L(0); PG8_MMA(0, 1, At, B1); PG8_BAR;
            PG8_LDA(At, 1, 1); PG8_STAGE(PG8_SA(1, 0), a3, voffA);
            PG8_BAR; PG8_WAIT_L(0); PG8_MMA(1, 0, At, B0); PG8_BAR; PG8_SCHED;
            PG8_STAGE(PG8_SB(1, 1), b3 + hstep, voffB);
            PG8_WAIT_V(6); PG8_BAR; PG8_MMA(1, 1, At, B1); PG8_BAR;
        }
        E(acc, cur, wr, wc, fr, fq);
        if (!has_next) break;
#pragma unroll
        for (int a = 0; a < 2; ++a)
#pragma unroll
            for (int b = 0; b < 2; ++b)
#pragma unroll
                for (int m = 0; m < 4; ++m)
#pragma unroll
                    for (int n = 0; n < 2; ++n) acc[a][b][m][n] = (f32x4){0.f, 0.f, 0.f, 0.f};
        cur = nxt; cA = nA; cB = nB; ++ui;
    }
    PG8_WAIT_V(0);
    if (wr == 0) PG8_BAR;
    PG8_BAR;
#undef PG8_SA
#undef PG8_SB
#undef PG8_STAGE
#undef PG8_LDA
#undef PG8_LDB
#undef PG8_MMA
#undef PG8_WAIT_V
#undef PG8_WAIT_L
#undef PG8_BAR
#undef PG8_SCHED
}
}
using pg8::Unit;
typedef const f32x4 (&AccRef)[2][2][4][2];

DI u32x4 pack8(f32x4 v0, f32x4 v1) { u32x4 w; w.x = pk2(v0[0], v0[1]); w.y = pk2(v0[2], v0[3]); w.z = pk2(v1[0], v1[1]); w.w = pk2(v1[2], v1[3]); return w; }
DI void unpack8(u32x4 w, f32x4& a, f32x4& b) {
    a[0] = __uint_as_float(w.x << 16); a[1] = __uint_as_float(w.x & 0xffff0000u); a[2] = __uint_as_float(w.y << 16); a[3] = __uint_as_float(w.y & 0xffff0000u);
    b[0] = __uint_as_float(w.z << 16); b[1] = __uint_as_float(w.z & 0xffff0000u); b[2] = __uint_as_float(w.w << 16); b[3] = __uint_as_float(w.w & 0xffff0000u);
}

struct EpiInproj {
    static constexpr bool PERM = true;
    bf16_t* P; float* fz;
    DI void operator()(AccRef acc, const Unit& u, int wr, int wc, int fr, int fq) const {
        const int row0 = u.pm * 256 + wr * 64 + fr, col0 = u.pn * 256 + wc * 32 + 8 * fq;
        const bool isf = (u.pn >= 4 && u.pn < 8);
#pragma unroll
        for (int ai = 0; ai < 2; ++ai)
#pragma unroll
            for (int m = 0; m < 4; ++m) { const size_t row = (size_t)(row0 + ai * 128 + m * 16);
#pragma unroll
                for (int bj = 0; bj < 2; ++bj) { const int c = col0 + bj * 128;
                    if (isf) { float* d = fz + row * DH + (c - 1024); *(f32x4*)d = acc[ai][bj][m][0]; *(f32x4*)(d + 4) = acc[ai][bj][m][1]; }
                    else *(u32x4*)(P + row * INC + c) = pack8(acc[ai][bj][m][0], acc[ai][bj][m][1]); } }
    }
};
struct EpiGlu {
    static constexpr bool PERM = true;
    const bf16_t* ys; bf16_t* os; const float* bias;
    DI void operator()(AccRef acc, const Unit& u, int wr, int wc, int fr, int fq) const {
        const int row0 = u.pm * 256 + wr * 64 + fr, col0 = u.pn * 256 + wc * 32 + 8 * fq;
#pragma unroll
        for (int bj = 0; bj < 2; ++bj) { const int c = col0 + bj * 128; const f32x4 b0 = *(const f32x4*)(bias + c), b1 = *(const f32x4*)(bias + c + 4);
#pragma unroll
            for (int ai = 0; ai < 2; ++ai)
#pragma unroll
                for (int m = 0; m < 4; ++m) { const size_t off = blk((size_t)(row0 + ai * 128 + m * 16), c, DH);
                    f32x4 y0, y1; unpack8(*(const u32x4*)(ys + off), y0, y1);
                    f32x4 v0 = acc[ai][bj][m][0] + b0, v1 = acc[ai][bj][m][1] + b1;
#pragma unroll
                    for (int j = 0; j < 4; ++j) { v0[j] = y0[j] * sigmoidf_(v0[j]); v1[j] = y1[j] * sigmoidf_(v1[j]); }
                    *(u32x4*)(os + off) = pack8(v0, v1); } }
    }
};
template <bool ADD> struct EpiMix {
    static constexpr bool PERM = true;
    const bf16_t* P; int gcol; bf16_t* mix;
    DI void operator()(AccRef acc, const Unit& u, int wr, int wc, int fr, int fq) const {
        const int row0 = u.pm * 256 + wr * 64 + fr, col0 = u.pn * 256 + wc * 32 + 8 * fq;
#pragma unroll
        for (int ai = 0; ai < 2; ++ai)
#pragma unroll
            for (int m = 0; m < 4; ++m) { const size_t row = (size_t)(row0 + ai * 128 + m * 16);
#pragma unroll
                for (int bj = 0; bj < 2; ++bj) { const int c = col0 + bj * 128;
                    f32x4 g0, g1; unpack8(*(const u32x4*)(P + row * INC + gcol + c), g0, g1);
                    f32x4 v0, v1;
#pragma unroll
                    for (int j = 0; j < 4; ++j) { v0[j] = sigmoidf_(g0[j]) * acc[ai][bj][m][0][j]; v1[j] = sigmoidf_(g1[j]) * acc[ai][bj][m][1][j]; }
                    const size_t mo = blk(row, c, DM);
                    if (ADD) { f32x4 p0, p1; unpack8(*(const u32x4*)(mix + mo), p0, p1); v0 += p0; v1 += p1; }
                    *(u32x4*)(mix + mo) = pack8(v0, v1); } }
    }
};
struct EpiResid {
    static constexpr bool PERM = false;
    const float* xp; const float* xs; float* xout; float* part;
    DI void operator()(AccRef acc, const Unit& u, int wr, int wc, int fr, int fq) const {
        if (u.kp >= 0) {
            float* slab = part + ((size_t)(u.slot * 8 + u.kp) << 16) + (size_t)(wr * 64 + fr) * 256 + wc * 32 + 4 * fq;
#pragma unroll
            for (int ai = 0; ai < 2; ++ai)
#pragma unroll
                for (int m = 0; m < 4; ++m)
#pragma unroll
                    for (int bj = 0; bj < 2; ++bj)
#pragma unroll
                        for (int n = 0; n < 2; ++n) *(f32x4*)(slab + (size_t)(ai * 128 + m * 16) * 256 + bj * 128 + n * 16) = acc[ai][bj][m][n];
            return; }
        const int row0 = u.pm * 256 + wr * 64 + fr, col0 = u.pn * 256 + wc * 32 + 4 * fq;
#pragma unroll
        for (int ai = 0; ai < 2; ++ai)
#pragma unroll
            for (int m = 0; m < 4; ++m) { const int row = row0 + ai * 128 + m * 16;
                const float* src = (row < TP) ? xp + (size_t)row * DM : xs + (size_t)(row - TP) * DM; float* dst = xout + (size_t)row * DM;
#pragma unroll
                for (int bj = 0; bj < 2; ++bj)
#pragma unroll
                    for (int n = 0; n < 2; ++n) { const int c = col0 + bj * 128 + n * 16; *(f32x4*)(dst + c) = *(const f32x4*)(src + c) + acc[ai][bj][m][n]; } }
    }
};
struct EpiSwiglu {
    static constexpr bool PERM = true;
    bf16_t* hid;
    DI void operator()(AccRef acc, const Unit& u, int wr, int wc, int fr, int fq) const {
        const int row0 = u.pm * 256 + wr * 64 + fr, col0 = u.pn * 128 + wc * 32 + 8 * fq;
#pragma unroll
        for (int ai = 0; ai < 2; ++ai)
#pragma unroll
            for (int m = 0; m < 4; ++m) { const size_t row = (size_t)(row0 + ai * 128 + m * 16);
                f32x4 v0, v1;
#pragma unroll
                for (int j = 0; j < 4; ++j) { const float a = acc[ai][0][m][0][j], b = acc[ai][0][m][1][j];
                    v0[j] = a * sigmoidf_(a) * acc[ai][1][m][0][j]; v1[j] = b * sigmoidf_(b) * acc[ai][1][m][1][j]; }
                *(u32x4*)(hid + blk(row, col0, DFF)) = pack8(v0, v1); }
    }
};

DI void transpose_item(const float* W, int K, int N, bf16_t* WT, int kb, int n0, int dst_row0, LAS float* scr, int lane) {
    const int k0 = 64 * kb;
    float wv[32];
#pragma unroll
    for (int i = 0; i < 32; ++i) wv[i] = W[(size_t)(k0 + 2 * i + (lane >> 5)) * N + n0 + (lane & 31)];
#pragma unroll
    for (int i = 0; i < 32; ++i) scr[(2 * i + (lane >> 5)) * 33 + (lane & 31)] = wv[i];
    __syncthreads();
    const int c = lane & 7;
#pragma unroll
    for (int j = 0; j < 4; ++j) { const int n = (lane >> 3) + 8 * j; const LAS float* s = scr + (8 * c) * 33 + n;
        u32x4 o; o.x = pk2(s[0 * 33], s[1 * 33]); o.y = pk2(s[2 * 33], s[3 * 33]); o.z = pk2(s[4 * 33], s[5 * 33]); o.w = pk2(s[6 * 33], s[7 * 33]);
        *(u32x4*)(WT + blk((size_t)(dst_row0 + n), k0 + 8 * c, K)) = o; }
    __syncthreads();
}
DI void phase_convert(const Ctx cx, const Params& p, int l, LAS unsigned char* lds) {
    const int tid = cx.tid, lane = tid & 63, w = tid >> 6;
    LAS float* scr = (LAS float*)(lds + w * 16384);
    const int gw = cx.bid * 8 + w, NGW = cx.nb * 8;
    constexpr int I_IN = (DM / 64) * (INC / 32), I_GLU = (DH / 64) * (DH / 32), I_BH = (DH / 64) * (DM / 32), I_OUT = (DM / 64) * (DM / 32), I_GU = (DM / 64) * (2 * DFF / 32), I_DN = (DFF / 64) * (DM / 32);
    constexpr int NITEMS = I_IN + I_GLU + 2 * I_BH + I_OUT + I_GU + I_DN;
    for (int it = gw; it < NITEMS; it += NGW) {
        int r = it;
        if (r < I_IN) { const int nb = INC / 32; transpose_item(p.in[7] + (size_t)l * DM * INC, DM, INC, (bf16_t*)(p.ws + WS_WIN), r / nb, 32 * (r % nb), 32 * (r % nb), scr, lane); continue; } r -= I_IN;
        if (r < I_GLU) { const int nb = DH / 32; transpose_item(p.in[18] + (size_t)l * DH * DH, DH, DH, (bf16_t*)(p.ws + WS_WGLU), r / nb, 32 * (r % nb), 32 * (r % nb), scr, lane); continue; } r -= I_GLU;
        if (r < I_BH) { const int nb = DM / 32; transpose_item(p.in[9] + (size_t)l * DH * DM, DH, DM, (bf16_t*)(p.ws + WS_WBH), r / nb, 32 * (r % nb), 32 * (r % nb), scr, lane); continue; } r -= I_BH;
        if (r < I_BH) { const int nb = DM / 32; transpose_item(p.in[20] + (size_t)l * DH * DM, DH, DM, (bf16_t*)(p.ws + WS_WBS), r / nb, 32 * (r % nb), 32 * (r % nb), scr, lane); continue; } r -= I_BH;
        if (r < I_OUT) { const int nb = DM / 32; transpose_item(p.in[21] + (size_t)l * DM * DM, DM, DM, (bf16_t*)(p.ws + WS_WOUT), r / nb, 32 * (r % nb), 32 * (r % nb), scr, lane); continue; } r -= I_OUT;
        if (r < I_GU) { const int nb = 2 * DFF / 32; const int n0 = 32 * (r % nb); const int jn = n0 < DFF ? n0 : n0 - DFF; const int dst = 256 * (jn / 128) + (n0 < DFF ? 0 : 128) + (jn % 128);
            transpose_item(p.in[23] + (size_t)l * DM * 2 * DFF, DM, 2 * DFF, (bf16_t*)(p.ws + WS_WGU), r / nb, n0, dst, scr, lane); continue; } r -= I_GU;
        { const int nb = DM / 32; transpose_item(p.in[24] + (size_t)l * DFF * DM, DFF, DM, (bf16_t*)(p.ws + WS_WDN), r / nb, 32 * (r % nb), 32 * (r % nb), scr, lane); }
    }
    const int gt = cx.bid * 512 + tid;
    if (gt < 4096) {
        const int g = gt >> 6, n = gt & 63;
        const float alr = p.in[10][l * 4096 + gt], aim = p.in[11][l * 4096 + gt], dt = expf(p.in[12][l * 64 + g]);
        const float lr = -expf(alr), li = aim, ar = lr * dt, ai = li * dt;
        const float er = expf(ar), cr = cosf(ai), sr = sinf(ai), sh = sinf(0.5f * ai);
        const float lbr = er * cr, lbi = er * sr;
        const float nr = expm1f(ar) * cr - 2.0f * sh * sh, ni = lbi;
        const float den = lr * lr + li * li, zr = (nr * lr + ni * li) / den, zi = (ni * lr - nr * li) / den;
        bf16_t* BmT = (bf16_t*)(p.ws + WS_BMT) + (size_t)g * 128 * 16; bf16_t* CmT = (bf16_t*)(p.ws + WS_CMT) + (size_t)g * 16 * 128;
        const float* bre = p.in[13] + ((size_t)(l * 64 + g) * 64 + n) * 16; const float* bim = p.in[14] + ((size_t)(l * 64 + g) * 64 + n) * 16;
#pragma unroll
        for (int q = 0; q < 16; ++q) { const float br = bre[q], bi = bim[q]; BmT[n * 16 + q] = f2bf(zr * br - zi * bi); BmT[(64 + n) * 16 + q] = f2bf(zr * bi + zi * br); }
        const float* cre = p.in[15] + (size_t)(l * 64 + g) * 16 * 64 + n; const float* cim = p.in[16] + (size_t)(l * 64 + g) * 16 * 64 + n;
#pragma unroll
        for (int q = 0; q < 16; ++q) { CmT[q * 128 + n] = f2bf(cre[q * 64]); CmT[q * 128 + 64 + n] = f2bf(-cim[q * 64]); }
        float* lamb = (float*)(p.ws + WS_LAMB) + g * 128; float* laml = (float*)(p.ws + WS_LAML) + g * 128;
        lamb[n] = lbr; lamb[64 + n] = lbi;
        float pr = lbr, pi = lbi;
#pragma unroll
        for (int s = 0; s < 8; ++s) { const float t = pr * pr - pi * pi; pi = 2.0f * pr * pi; pr = t; }
        laml[n] = pr; laml[64 + n] = pi;
    }
}
template <bool TO_BF16, bool FIX> DI void phase_rmsnorm(const Ctx cx, const float* xp, const float* xs, const float* w, bf16_t* ob, float* of,
                                                         const float* part, const float* bp, const float* bs, float* xfix, LAS unsigned char* lds) {
    const int lane = cx.tid & 63, gw = cx.bid * 8 + (cx.tid >> 6), NGW = cx.nb * 8;
    LAS unsigned char* smap = lds;
    if (FIX) {
        for (int i = cx.tid; i < 68 * 8; i += 512) smap[i] = 0;
        __syncthreads();
        if (cx.tid < 32 && cx.nb == 256) { int pm, pn; pg8::map_unit(512 + cx.tid, T / 256, DM / 256, (T / 256) * (DM / 256), pm, pn); smap[pm * 8 + pn] = (unsigned char)(cx.tid + 1); }
        __syncthreads();
    }
    for (int row = gw; row < T; row += NGW) {
        const float* src = (row < TP) ? xp + (size_t)row * DM : xs + (size_t)(row - TP) * DM;
        f32x4 v[8]; float s = 0.f;
#pragma unroll
        for (int j = 0; j < 8; ++j) v[j] = ((const f32x4*)src)[lane + 64 * j];
        if (FIX) {
            const float* bsrc = (row < TP) ? bp + (size_t)row * DM : bs + (size_t)(row - TP) * DM;
#pragma unroll
            for (int j = 0; j < 8; ++j) { const int sj = smap[(row >> 8) * 8 + j];
                if (sj) { f32x4 a = ((const f32x4*)bsrc)[lane + 64 * j]; const float* pp = part + ((size_t)((sj - 1) * 8) << 16) + (size_t)(row & 255) * 256 + 4 * lane;
#pragma unroll
                    for (int kp = 0; kp < 8; ++kp) a += *(const f32x4*)(pp + ((size_t)kp << 16));
                    v[j] = a; ((f32x4*)(xfix + (size_t)row * DM))[lane + 64 * j] = a; } }
        }
#pragma unroll
        for (int j = 0; j < 8; ++j) s += (v[j][0] * v[j][0] + v[j][1] * v[j][1]) + (v[j][2] * v[j][2] + v[j][3] * v[j][3]);
        const float r = 1.0f / sqrtf(wave_sum(s) * (1.0f / DM) + 1e-6f);
#pragma unroll
        for (int j = 0; j < 8; ++j) { const f32x4 wv = ((const f32x4*)w)[lane + 64 * j]; const f32x4 o = v[j] * r * wv;
            if (TO_BF16) { u32x2 q; q.x = pk2(o[0], o[1]); q.y = pk2(o[2], o[3]); *(u32x2*)(ob + blk((size_t)row, 4 * (lane + 64 * j), DM)) = q; }
            else ((f32x4*)(of + (size_t)row * DM))[lane + 64 * j] = o; }
    }
}

template <bool OUT>
DI void hgrn_item(const Ctx cx, const Params& p, int l, int h, int row0, int nmacro, int nsub, const float* Sinit, float* Sout, float* Dout, LAS unsigned char* lds) {
    const int tid = cx.tid, lane = tid & 63, w = tid >> 6, l15 = lane & 15, quad = lane >> 4;
    LAS bf16_t* qt = (LAS bf16_t*)lds;
    LAS bf16_t* kt = qt + 64 * 136;
    LAS bf16_t* keT = kt + 64 * 136;
    LAS bf16_t* vT = keT + 128 * 72;
    LAS float* Dl = (LAS float*)(vT + 128 * 72);
    LAS float* Ll = Dl + 512;
    LAS float* ob = Ll + 512;
    const bf16_t* P = (const bf16_t*)(p.ws + WS_P);
    const float* fz = (const float*)(p.ws + WS_FZ);
    bf16_t* oh = (bf16_t*)(p.ws + WS_OH);
    f32x4 S[8];
#pragma unroll
    for (int i = 0; i < 8; ++i)
#pragma unroll
        for (int r = 0; r < 4; ++r) S[i][r] = Sinit ? Sinit[(size_t)(16 * i + quad * 4 + r) * 128 + 16 * w + l15] : 0.f;
    const int sj = tid >> 7, sc = tid & 127, scol = h * 128 + sc;
    float lb = 0.f;
    if (l == 1) { const float l0 = p.in[5][scol], l1 = p.in[5][DH + scol]; lb = 1.0f / (1.0f + expf(l0 - l1)); }
    const float oml = 1.0f - lb;
    float totlog = 0.f;
    float zc[16]; bf16_t qc[16], ic[16];
    if (sj < nsub) {
#pragma unroll
        for (int i = 0; i < 16; ++i) { const size_t r = (size_t)row0 + 16 * sj + i; zc[i] = fz[r * DH + scol]; ic[i] = P[r * INC + C_I + scol]; qc[i] = OUT ? P[r * INC + C_Q + scol] : (bf16_t)0; }
    }
    for (int mc = 0; mc < nmacro; ++mc) {
        lds_barrier();
        if (sj < nsub) {
            float bl[16], kv[16]; float run = 0.f;
#pragma unroll
            for (int i = 0; i < 16; ++i) {
                const float z = zc[i];
                const float e = __expf(-fabsf(z)), rc = 1.0f / (1.0f + e);
                const float lsig = fminf(z, 0.f) - __logf(1.0f + e);
                const float sig = z >= 0.f ? rc : e * rc, nsig = z >= 0.f ? e * rc : rc;
                const float lf = (l == 0) ? lsig : __logf(lb + oml * sig);
                kv[i] = oml * nsig; run += lf; bl[i] = run;
            }
            unsigned kp[8], vp[8];
#pragma unroll
            for (int i = 0; i < 16; i += 2) {
                float ke[2], vv[2];
#pragma unroll
                for (int d = 0; d < 2; ++d) {
                    const float iv = bf2f(ic[i + d]);
                    if (OUT) { const float q = bf2f(qc[i + d]);
                        qt[(16 * sj + i + d) * 136 + sc] = f2bf(q * __expf(bl[i + d]));
                        kt[(16 * sj + i + d) * 136 + sc] = f2bf(kv[i + d] * __expf(fminf(-bl[i + d], 80.f))); }
                    ke[d] = kv[i + d] * __expf(run - bl[i + d]);
                    vv[d] = iv * sigmoidf_(iv);
                }
                kp[i >> 1] = pk2(ke[0], ke[1]); vp[i >> 1] = pk2(vv[0], vv[1]);
            }
            *(LAS u32x4*)(keT + sc * 72 + 16 * sj) = (u32x4){kp[0], kp[1], kp[2], kp[3]}; *(LAS u32x4*)(keT + sc * 72 + 16 * sj + 8) = (u32x4){kp[4], kp[5], kp[6], kp[7]};
            *(LAS u32x4*)(vT + sc * 72 + 16 * sj) = (u32x4){vp[0], vp[1], vp[2], vp[3]}; *(LAS u32x4*)(vT + sc * 72 + 16 * sj + 8) = (u32x4){vp[4], vp[5], vp[6], vp[7]};
            Dl[sj * 128 + sc] = __expf(run); Ll[sj * 128 + sc] = run;
            if (mc + 1 < nmacro) {
#pragma unroll
                for (int i = 0; i < 16; ++i) { const size_t r = (size_t)row0 + (size_t)(mc + 1) * 64 + 16 * sj + i; zc[i] = fz[r * DH + scol]; ic[i] = P[r * INC + C_I + scol]; qc[i] = OUT ? P[r * INC + C_Q + scol] : (bf16_t)0; }
            }
        }
        lds_barrier();
        if (tid < 128) { for (int j = 0; j < nsub; ++j) totlog += Ll[j * 128 + tid]; }
#pragma unroll 1
        for (int j = 0; j < nsub; ++j) {
            const bf16x4 v4 = *(const LAS bf16x4*)(vT + (16 * w + l15) * 72 + 16 * j + quad * 4);
            const bf16x8 vB = mk8(v4, (bf16x4){0, 0, 0, 0});
            if (OUT) {
                f32x4 oacc = {0.f, 0.f, 0.f, 0.f};
#pragma unroll
                for (int kk = 0; kk < 4; ++kk) {
                    const bf16x8 bS = mk8u(pk2(S[2 * kk][0], S[2 * kk][1]), pk2(S[2 * kk][2], S[2 * kk][3]), pk2(S[2 * kk + 1][0], S[2 * kk + 1][1]), pk2(S[2 * kk + 1][2], S[2 * kk + 1][3]));
                    const bf16x4 a0 = *(const LAS bf16x4*)(qt + (16 * j + l15) * 136 + 32 * kk + quad * 4);
                    const bf16x4 a1 = *(const LAS bf16x4*)(qt + (16 * j + l15) * 136 + 32 * kk + 16 + quad * 4);
                    oacc = MFMA16(mk8(a0, a1), bS, oacc);
                }
                f32x4 pt = {0.f, 0.f, 0.f, 0.f};
#pragma unroll
                for (int kk = 0; kk < 4; ++kk) {
                    const bf16x8 aK = *(const LAS bf16x8*)(kt + (16 * j + l15) * 136 + 32 * kk + quad * 8);
                    const bf16x8 bQ = *(const LAS bf16x8*)(qt + (16 * j + l15) * 136 + 32 * kk + quad * 8);
                    pt = MFMA16(aK, bQ, pt);
                }
#pragma unroll
                for (int r = 0; r < 4; ++r) if (quad * 4 + r > l15) pt[r] = 0.f;
                const bf16x8 aP = mk8u(pk2(pt[0], pt[1]), pk2(pt[2], pt[3]), 0u, 0u);
                oacc = MFMA16(aP, vB, oacc);
#pragma unroll
                for (int r = 0; r < 4; ++r) ob[(16 * j + quad * 4 + r) * 132 + 16 * w + l15] = oacc[r];
            }
#pragma unroll
            for (int i = 0; i < 8; ++i) {
                const f32x4 d = *(const LAS f32x4*)(Dl + j * 128 + 16 * i + quad * 4);
                const bf16x4 k4 = *(const LAS bf16x4*)(keT + (16 * i + l15) * 72 + 16 * j + quad * 4);
                S[i] = MFMA16(mk8(k4, (bf16x4){0, 0, 0, 0}), vB, S[i] * d);
            }
        }
        if (OUT) {
            lds_barrier();
            const int t = tid >> 3, c8 = tid & 7;
            if (t < nsub * 16) {
                f32x4 ov[4]; float s = 0.f;
#pragma unroll
                for (int q = 0; q < 4; ++q) { ov[q] = *(const LAS f32x4*)(ob + t * 132 + 16 * c8 + 4 * q); s += (ov[q][0] * ov[q][0] + ov[q][1] * ov[q][1]) + (ov[q][2] * ov[q][2] + ov[q][3] * ov[q][3]); }
                s += __shfl_xor(s, 1); s += __shfl_xor(s, 2); s += __shfl_xor(s, 4);
                const float rs = 1.0f / sqrtf(s * (1.0f / 128.0f) + 1e-6f);
                const size_t row = (size_t)row0 + (size_t)mc * 64 + t; const int colg = h * 128 + 16 * c8;
                const float* gn = p.in[8] + l * DH + colg;
#pragma unroll
                for (int hf = 0; hf < 2; ++hf) {
                    f32x4 g0, g1; unpack8(*(const u32x4*)(P + row * INC + C_G + colg + 8 * hf), g0, g1);
                    const f32x4 n0 = *(const f32x4*)(gn + 8 * hf), n1 = *(const f32x4*)(gn + 8 * hf + 4);
                    f32x4 r0, r1;
#pragma unroll
                    for (int q = 0; q < 4; ++q) { r0[q] = ov[2 * hf][q] * rs * n0[q] * g0[q] * sigmoidf_(g0[q]); r1[q] = ov[2 * hf + 1][q] * rs * n1[q] * g1[q] * sigmoidf_(g1[q]); }
                    *(u32x4*)(oh + blk(row, colg + 8 * hf, DH)) = pack8(r0, r1);
                }
            }
        }
    }
    if (Sout) {
#pragma unroll
        for (int i = 0; i < 8; ++i)
#pragma unroll
            for (int r = 0; r < 4; ++r) Sout[(size_t)(16 * i + quad * 4 + r) * 128 + 16 * w + l15] = S[i][r];
    }
    if (Dout && tid < 128) Dout[tid] = __expf(totlog);
}

template <bool OUT>
DI void s5_task(const Ctx cx, const Params& p, int l, int g, int row0, int ntiles, float& xr, float& xi, LAS unsigned char* wl) {
    const int lane = cx.tid & 63, l15 = lane & 15, quad = lane >> 4;
    const bf16_t* P = (const bf16_t*)(p.ws + WS_P);
    const bf16_t* BmT = (const bf16_t*)(p.ws + WS_BMT) + (size_t)g * 128 * 16; const bf16_t* CmT = (const bf16_t*)(p.ws + WS_CMT) + (size_t)g * 16 * 128;
    const float* lamb = (const float*)(p.ws + WS_LAMB) + g * 128;
    bf16_t* ys = (bf16_t*)(p.ws + WS_YS);
    const float lam_r = lamb[lane], lam_i = lamb[64 + lane];
    const bf16x8 zero8 = {0, 0, 0, 0, 0, 0, 0, 0};
    bf16x8 bB[8], bC[4];
#pragma unroll
    for (int t = 0; t < 8; ++t) bB[t] = quad < 2 ? *(const bf16x8*)(BmT + (16 * t + l15) * 16 + quad * 8) : zero8;
#pragma unroll
    for (int kk = 0; kk < 4; ++kk) bC[kk] = OUT ? *(const bf16x8*)(CmT + l15 * 128 + 32 * kk + quad * 8) : zero8;
    const float dsk = p.in[17][l * DH + g * 16 + l15];
    LAS float* bu = (LAS float*)wl;
    LAS bf16_t* xs = (LAS bf16_t*)(wl + 8448);
    const bf16_t* pu = P + (size_t)row0 * INC + C_U + g * 16;
    bf16x8 aUn = quad < 2 ? *(const bf16x8*)(pu + (size_t)l15 * INC + quad * 8) : zero8;
    bf16_t uvn[4];
#pragma unroll
    for (int r = 0; r < 4; ++r) uvn[r] = OUT ? pu[(size_t)(quad * 4 + r) * INC + l15] : (bf16_t)0;
#pragma unroll 1
    for (int t0 = 0; t0 < ntiles; ++t0) {
        const size_t rowb = (size_t)row0 + 16 * t0;
        const bf16x8 aU = aUn; bf16_t uvc[4];
#pragma unroll
        for (int r = 0; r < 4; ++r) uvc[r] = uvn[r];
        if (t0 + 1 < ntiles) {
            const bf16_t* pn = pu + (size_t)(16 * (t0 + 1)) * INC;
            aUn = quad < 2 ? *(const bf16x8*)(pn + (size_t)l15 * INC + quad * 8) : zero8;
            if (OUT) {
#pragma unroll
                for (int r = 0; r < 4; ++r) uvn[r] = pn[(size_t)(quad * 4 + r) * INC + l15]; }
        }
#pragma unroll
        for (int t = 0; t < 8; ++t) { const f32x4 c = MFMA16(aU, bB[t], ((f32x4){0.f, 0.f, 0.f, 0.f}));
#pragma unroll
            for (int r = 0; r < 4; ++r) bu[(quad * 4 + r) * 132 + 16 * t + l15] = c[r]; }
        __syncthreads();
#pragma unroll
        for (int t = 0; t < 16; ++t) { const float re = bu[t * 132 + lane], im = bu[t * 132 + 64 + lane];
            const float nr = lam_r * xr - lam_i * xi + re, ni = lam_r * xi + lam_i * xr + im; xr = nr; xi = ni;
            if (OUT) { xs[t * 136 + lane] = f2bf(xr); xs[t * 136 + 64 + lane] = f2bf(xi); } }
        __syncthreads();
        if (OUT) {
            f32x4 y = {0.f, 0.f, 0.f, 0.f};
#pragma unroll
            for (int kk = 0; kk < 4; ++kk) { const bf16x8 aX = *(const LAS bf16x8*)(xs + l15 * 136 + 32 * kk + quad * 8); y = MFMA16(aX, bC[kk], y); }
#pragma unroll
            for (int r = 0; r < 4; ++r) { const size_t row = rowb + quad * 4 + r;
                const float uv = bf2f(uvc[r]);
                const float v = y[r] + dsk * uv;
                const float a = 0.7978845608028654f * (v + 0.044715f * v * v * v);
                const float th = 1.0f - 2.0f * __builtin_amdgcn_rcpf(1.0f + __expf(2.0f * a));
                ys[blk(row, g * 16 + l15, DH)] = f2bf(0.5f * v * (1.0f + th)); }
            __syncthreads();
        }
    }
}

DI void run_phase(const Ctx cx, const Params& p, int ph, LAS unsigned char* lds) {
    const int l = ph / NPH_LAYER, k = ph % NPH_LAYER;
    const int tid = cx.tid, w = tid >> 6, lane = tid & 63, bid = cx.bid, nb = cx.nb;
    float* xres = p.out + O_Y;
    pg8::StaticOrder S;
    const float* part = (const float*)(p.ws + WS_PART);
    if (ph == 2 * NPH_LAYER) { phase_rmsnorm<false, true>(cx, xres, xres + (size_t)TP * DM, p.in[25], nullptr, xres, part, xres, xres + (size_t)TP * DM, xres, lds); return; }
    switch (k) {
    case 0: {
        phase_convert(cx, p, l, lds);
        const float* xa = l == 0 ? p.in[0] : xres; const float* xb = l == 0 ? p.in[1] : xres + (size_t)TP * DM;
        if (l == 0) phase_rmsnorm<true, false>(cx, xa, xb, p.in[6], (bf16_t*)(p.ws + WS_HB), nullptr, nullptr, nullptr, nullptr, nullptr, lds);
        else phase_rmsnorm<true, true>(cx, xa, xb, p.in[6] + DM, (bf16_t*)(p.ws + WS_HB), nullptr, part, xa, xb, xres, lds);
    } break;
    case 1: {
        S.init(T, INC, DM, nb, bid, 0);
        pg8::gemm_phase(cx, lds, pg8::Gemm{(const bf16_t*)(p.ws + WS_HB), (const bf16_t*)(p.ws + WS_WIN), T, INC, DM}, S, EpiInproj{(bf16_t*)(p.ws + WS_P), (float*)(p.ws + WS_FZ)});
    } break;
    case 2: {
        float* seg = (float*)(p.ws + WS_SEG); float* dseg = (float*)(p.ws + WS_DSEG);
        for (int it = bid; it < NHSEG * 8; it += nb) { const int sg = it >> 3, h = it & 7;
            hgrn_item<false>(cx, p, l, h, sg * HSEG, HSEG / 64, 4, nullptr, seg + (size_t)it * 16384, dseg + it * 128, lds); }
        __syncthreads();
        float* E = (float*)(p.ws + WS_S5E);
        for (int tk = bid * 8 + w; tk < (NSSEG - 1) * 64; tk += nb * 8) { const int sg = tk >> 6, g = tk & 63;
            float xr = 0.f, xi = 0.f; s5_task<false>(cx, p, l, g, sg * SSEG, SSEG / 16, xr, xi, lds + w * 12800);
            E[(size_t)tk * 128 + lane] = xr; E[(size_t)tk * 128 + 64 + lane] = xi; }
    } break;
    case 3: {
        float* seg = (float*)(p.ws + WS_SEG); const float* dseg = (const float*)(p.ws + WS_DSEG);
        for (int e = bid * 512 + tid; e < 8 * 16384; e += nb * 512) { const int h = e >> 14, rem = e & 16383, dk = rem >> 7;
            float Sv = 0.f; float Lv[NHSEG], Dv[NHSEG];
#pragma unroll
            for (int sg = 0; sg < NHSEG; ++sg) { Lv[sg] = seg[(size_t)(sg * 8 + h) * 16384 + rem]; Dv[sg] = dseg[(sg * 8 + h) * 128 + dk]; }
#pragma unroll
            for (int sg = 0; sg < NHSEG; ++sg) { seg[(size_t)(sg * 8 + h) * 16384 + rem] = Sv; Sv = Dv[sg] * Sv + Lv[sg]; }
            p.out[O_HP + (size_t)l * 131072 + e] = Sv; }
    } break;
    case 4: {
        float* seg = (float*)(p.ws + WS_SEG);
#ifndef HREP
#define HREP 1
#endif
#ifndef SREP
#define SREP 1
#endif
        for (int rep = 0; rep < HREP; ++rep)
        for (int it = bid; it < NHSEG * 8 + 32 * 8; it += nb) {
            const bool pr = it < NHSEG * 8; const int i2 = pr ? it : it - NHSEG * 8; const int a = i2 >> 3, h = i2 & 7;
            const size_t so = ((size_t)(l * 32 + a) * 8 + h) * 16384;
            const float* sin_ = pr ? seg + (size_t)it * 16384 : p.in[2] + so; float* sout_ = pr ? nullptr : p.out + O_HS + so;
            hgrn_item<true>(cx, p, l, h, pr ? a * HSEG : TP + a * 32, pr ? HSEG / 64 : 1, pr ? 4 : 2, sin_, sout_, nullptr, lds); }
        __syncthreads();
        const float* E = (const float*)(p.ws + WS_S5E); const float* laml = (const float*)(p.ws + WS_LAML);
        for (int rep = 0; rep < SREP; ++rep)
        for (int tk = bid * 8 + w; tk < NSSEG * 64 + 32 * 64; tk += nb * 8) {
            const bool pr = tk < NSSEG * 64; const int t2 = pr ? tk : tk - NSSEG * 64; const int a = t2 >> 6, g = t2 & 63;
            const size_t so = ((size_t)(l * 32 + a) * 64 + g) * 64 + lane;
            float xr = 0.f, xi = 0.f;
            if (pr) { const float Lr = laml[g * 128 + lane], Li = laml[g * 128 + 64 + lane];
                int j = 0;
                for (; j + 8 <= a; j += 8) { float er[8], ei[8];
#pragma unroll
                    for (int q = 0; q < 8; ++q) { er[q] = E[(size_t)((j + q) * 64 + g) * 128 + lane]; ei[q] = E[(size_t)((j + q) * 64 + g) * 128 + 64 + lane]; }
#pragma unroll
                    for (int q = 0; q < 8; ++q) { const float nr = Lr * xr - Li * xi + er[q], ni = Lr * xi + Li * xr + ei[q]; xr = nr; xi = ni; } }
                for (; j < a; ++j) { const float er = E[(size_t)(j * 64 + g) * 128 + lane], ei = E[(size_t)(j * 64 + g) * 128 + 64 + lane];
                    const float nr = Lr * xr - Li * xi + er, ni = Lr * xi + Li * xr + ei; xr = nr; xi = ni; } }
            else { xr = p.in[3][so]; xi = p.in[4][so]; }
            s5_task<true>(cx, p, l, g, pr ? a * SSEG : TP + a * 32, pr ? SSEG / 16 : 2, xr, xi, lds + w * 12800);
            if (!pr) { p.out[O_SRS + so] = xr; p.out[O_SIS + so] = xi; }
            else if (a == NSSEG - 1) { p.out[O_SRP + (size_t)l * 4096 + g * 64 + lane] = xr; p.out[O_SIP + (size_t)l * 4096 + g * 64 + lane] = xi; }
        }
    } break;
    case 5: {
        S.init(T, DH, DH, nb, bid, 0);
        pg8::gemm_phase(cx, lds, pg8::Gemm{(const bf16_t*)(p.ws + WS_YS), (const bf16_t*)(p.ws + WS_WGLU), T, DH, DH}, S, EpiGlu{(const bf16_t*)(p.ws + WS_YS), (bf16_t*)(p.ws + WS_OS), p.in[19] + l * DH});
        S.init(T, DM, DH, nb, (bid + 128) % nb, 0);
        pg8::gemm_phase(cx, lds, pg8::Gemm{(const bf16_t*)(p.ws + WS_OH), (const bf16_t*)(p.ws + WS_WBH), T, DM, DH}, S, EpiMix<false>{(const bf16_t*)(p.ws + WS_P), C_GH, (bf16_t*)(p.ws + WS_MIX)});
    } break;
    case 6: {
        S.init(T, DM, DH, nb, bid, 0);
        pg8::gemm_phase(cx, lds, pg8::Gemm{(const bf16_t*)(p.ws + WS_OS), (const bf16_t*)(p.ws + WS_WBS), T, DM, DH}, S, EpiMix<true>{(const bf16_t*)(p.ws + WS_P), C_GS, (bf16_t*)(p.ws + WS_MIX)});
    } break;
    case 7: {
        S.init(T, DM, DM, nb, bid, nb == 256 ? 8 : 0);
        const float* xa = l == 0 ? p.in[0] : xres; const float* xb = l == 0 ? p.in[1] : xres + (size_t)TP * DM;
        pg8::gemm_phase(cx, lds, pg8::Gemm{(const bf16_t*)(p.ws + WS_MIX), (const bf16_t*)(p.ws + WS_WOUT), T, DM, DM}, S, EpiResid{xa, xb, xres, (float*)(p.ws + WS_PART)});
    } break;
    case 8: {
        phase_rmsnorm<true, true>(cx, xres, xres + (size_t)TP * DM, p.in[22] + l * DM, (bf16_t*)(p.ws + WS_HB), nullptr, part, l == 0 ? p.in[0] : xres, l == 0 ? p.in[1] : xres + (size_t)TP * DM, xres, lds);
    } break;
    case 9: {
        S.init(T, 2 * DFF, DM, nb, bid, 0);
        pg8::gemm_phase(cx, lds, pg8::Gemm{(const bf16_t*)(p.ws + WS_HB), (const bf16_t*)(p.ws + WS_WGU), T, 2 * DFF, DM}, S, EpiSwiglu{(bf16_t*)(p.ws + WS_HID)});
    } break;
    case 10: {
        S.init(T, DM, DFF, nb, bid, nb == 256 ? 8 : 0);
        pg8::gemm_phase(cx, lds, pg8::Gemm{(const bf16_t*)(p.ws + WS_HID), (const bf16_t*)(p.ws + WS_WDN), T, DM, DFF}, S, EpiResid{xres, xres + (size_t)TP * DM, xres, (float*)(p.ws + WS_PART)});
    } break;
    }
}

DI void grid_seam(const Ctx cx, unsigned* bar, int bi) {
    asm volatile("s_waitcnt vmcnt(0) lgkmcnt(0)" ::: "memory");
    __syncthreads();
    if (cx.tid == 0) { __builtin_amdgcn_fence(__ATOMIC_RELEASE, "agent"); asm volatile("s_waitcnt vmcnt(0)" ::: "memory"); }
    if (bi < 0) cg::this_grid().sync();
    if (cx.tid == 0) {
        __hip_atomic_fetch_add(bar, 1u, __ATOMIC_RELAXED, __HIP_MEMORY_SCOPE_AGENT);
        const unsigned target = (unsigned)(bi + 1) * (unsigned)cx.nb;
        while (__hip_atomic_load(bar, __ATOMIC_RELAXED, __HIP_MEMORY_SCOPE_AGENT) < target) __builtin_amdgcn_s_sleep(1);
        __builtin_amdgcn_fence(__ATOMIC_ACQUIRE, "agent"); asm volatile("s_waitcnt vmcnt(0)" ::: "memory");
    }
    __syncthreads();
}

__global__ __launch_bounds__(512, 2) void mega_fwd(Params p, int ph_lo, int ph_hi) {
    extern __shared__ __attribute__((aligned(16))) unsigned char shm[];
    LAS unsigned char* lds = (LAS unsigned char*)shm;
    for (int ph = ph_lo; ph < ph_hi; ++ph) {
        Ctx cx; cx.tid = threadIdx.x; cx.bid = blockIdx.x; cx.nb = gridDim.x;
        asm volatile("" : "+v"(cx.tid)); asm volatile("" : "+s"(cx.bid), "+s"(cx.nb));
        run_phase(cx, p, ph, lds);
        if (ph + 1 < ph_hi) grid_seam(cx, (unsigned*)(p.ws + WS_BAR), ph - ph_lo);
    }
}

extern "C" void kernel_launch(void* const* d_in, const int* in_sizes, int n_in, void* d_out, int out_size, void* d_ws, size_t ws_size, hipStream_t stream) {
    static int grid_blocks = 0;
    if (grid_blocks == 0) {
        if (n_in != 26 || ws_size < WS_END) { fprintf(stderr, "kernel_launch: unexpected n_in %d / ws_size %zu (need %zu)\n", n_in, ws_size, (size_t)WS_END); grid_blocks = -1; return; }
        int dev = 0, cus = 0, per_cu = 0;
        hipGetDevice(&dev);
        hipDeviceGetAttribute(&cus, hipDeviceAttributeMultiprocessorCount, dev);
        if (hipFuncSetAttribute((const void*)mega_fwd, hipFuncAttributeMaxDynamicSharedMemorySize, LDS_BYTES) != hipSuccess) { fprintf(stderr, "kernel_launch: hipFuncSetAttribute failed\n"); grid_blocks = -1; return; }
        if (hipOccupancyMaxActiveBlocksPerMultiprocessor(&per_cu, (const void*)mega_fwd, 512, LDS_BYTES) != hipSuccess || per_cu < 1) { fprintf(stderr, "kernel_launch: occupancy query gave %d\n", per_cu); per_cu = 1; (void)hipGetLastError(); }
        grid_blocks = cus * per_cu;
    }
    if (grid_blocks < 0) return;
    Params p{};
    for (int i = 0; i < 26; ++i) p.in[i] = (const float*)d_in[i];
    p.out = (float*)d_out; p.ws = (unsigned char*)d_ws;
#if COOP
    if (hipMemsetAsync((char*)d_ws + WS_BAR, 0, 4096, stream) != hipSuccess) { fprintf(stderr, "kernel_launch: memset of the barrier words failed\n"); return; }
    int lo = 0, hi = NPHASES;
    void* args[] = {&p, &lo, &hi};
    hipError_t e = hipLaunchCooperativeKernel((const void*)mega_fwd, dim3(grid_blocks), dim3(512), args, LDS_BYTES, stream);
    if (e != hipSuccess) fprintf(stderr, "cooperative launch failed: %s (grid %d)\n", hipGetErrorString(e), grid_blocks);
#else
    for (int ph = 0; ph < NPHASES; ++ph) hipLaunchKernelGGL(mega_fwd, dim3(grid_blocks), dim3(512), LDS_BYTES, stream, p, ph, ph + 1);
#endif
}
```

```cpp
#include <hip/hip_runtime.h>
#include <hip/hip_cooperative_groups.h>
#include <cstdio>
namespace cg = cooperative_groups;

#ifndef COOP
#define COOP 1
#endif

#define LAS __attribute__((address_space(3)))
#define DI __device__ __forceinline__
typedef unsigned short bf16_t;
typedef short bf16x8 __attribute__((ext_vector_type(8)));
typedef short bf16x4 __attribute__((ext_vector_type(4)));
typedef float f32x4 __attribute__((ext_vector_type(4)));
typedef float f32x2 __attribute__((ext_vector_type(2)));
typedef unsigned u32x4 __attribute__((ext_vector_type(4)));
typedef unsigned u32x2 __attribute__((ext_vector_type(2)));
typedef __bf16 bfv2 __attribute__((ext_vector_type(2)));

constexpr int TP = 16384, TS = 1024, T = TP + TS, DM = 2048, DH = 1024, NHEAD = 8, NG = 64, DFF = 5632, INC = 9216;
constexpr int C_Q = 0, C_I = 2048, C_G = 3072, C_U = 4096, C_GH = 5120, C_GS = 7168;
constexpr int HSEG = 512, NHSEG = TP / HSEG;
constexpr int SSEG = 256, NSSEG = TP / SSEG;
constexpr size_t O_Y = 0, O_HP = (size_t)T * DM, O_SRP = O_HP + 262144, O_SIP = O_SRP + 8192, O_HS = O_SIP + 8192, O_SRS = O_HS + 8388608, O_SIS = O_SRS + 262144;
constexpr size_t WS_WIN = 0, WS_WGLU = WS_WIN + (size_t)INC * DM * 2, WS_WBH = WS_WGLU + (size_t)DH * DH * 2, WS_WBS = WS_WBH + (size_t)DM * DH * 2,
                 WS_WOUT = WS_WBS + (size_t)DM * DH * 2, WS_WGU = WS_WOUT + (size_t)DM * DM * 2, WS_WDN = WS_WGU + (size_t)2 * DFF * DM * 2,
                 WS_HB = WS_WDN + (size_t)DM * DFF * 2, WS_OH = WS_HB, WS_YS = WS_HB + (size_t)T * DH * 2,
                 WS_P = WS_HB + (size_t)T * DM * 2, WS_HID = WS_P,
                 WS_FZ = WS_P + (size_t)T * INC * 2, WS_MIX = WS_FZ,
                 WS_OS = WS_FZ + (size_t)T * DH * 4,
                 WS_SEG = WS_OS + (size_t)T * DH * 2, WS_DSEG = WS_SEG + (size_t)NHSEG * 8 * 16384 * 4,
                 WS_S5E = WS_DSEG + (size_t)NHSEG * 8 * 128 * 4,
                 WS_LAMB = WS_S5E + (size_t)NSSEG * 64 * 128 * 4, WS_LAML = WS_LAMB + 64 * 128 * 4, WS_BMT = WS_LAML + 64 * 128 * 4, WS_CMT = WS_BMT + 64 * 128 * 16 * 2,
                 WS_BAR = WS_CMT + 64 * 16 * 128 * 2, WS_PART = WS_BAR + 4096, WS_END = WS_PART + (size_t)32 * 8 * 65536 * 4;
constexpr int LDS_BYTES = 131072;
constexpr int NPH_LAYER = 11, NPHASES = 2 * NPH_LAYER + 1;

struct Params { const float* in[26]; float* out; unsigned char* ws; };
struct Ctx { int tid, bid, nb; };

DI float bf2f(bf16_t b) { return __uint_as_float(((unsigned)b) << 16); }
DI unsigned pk2(float lo, float hi) { f32x2 v = {lo, hi}; bfv2 b = __builtin_convertvector(v, bfv2); return __builtin_bit_cast(unsigned, b); }
DI bf16_t f2bf(float f) { return (bf16_t)(pk2(f, 0.f) & 0xffffu); }
DI float sigmoidf_(float v) { return __builtin_amdgcn_rcpf(1.0f + __expf(-v)); }
DI float wave_sum(float v) {
#pragma unroll
    for (int o = 1; o < 64; o <<= 1) v += __shfl_xor(v, o);
    return v;
}
DI void lds_fence() { asm volatile("s_waitcnt lgkmcnt(0)" ::: "memory"); }
DI void lds_barrier() { asm volatile("s_waitcnt lgkmcnt(0)" ::: "memory"); __builtin_amdgcn_s_barrier(); asm volatile("" ::: "memory"); }
DI bf16x8 mk8(bf16x4 a, bf16x4 b) { bf16x8 r; r[0] = a[0]; r[1] = a[1]; r[2] = a[2]; r[3] = a[3]; r[4] = b[0]; r[5] = b[1]; r[6] = b[2]; r[7] = b[3]; return r; }
DI bf16x8 mk8u(unsigned a, unsigned b, unsigned c, unsigned d) { u32x4 v = {a, b, c, d}; return __builtin_bit_cast(bf16x8, v); }
#define MFMA16(a, b, c) __builtin_amdgcn_mfma_f32_16x16x32_bf16((a), (b), (c), 0, 0, 0)

namespace pg8 {
constexpr int BM = 256, BK = 64, HALF = 128, HTB = HALF * BK * 2, STAGE_BYTES = 8 * HTB, NXCD = 8, WGM = 8;
DI int lds_byte(int r, int c) { const int st = (r >> 4) * 2 + (c >> 5), rr = r & 15, cc = c & 31, ob = rr * 64 + cc * 2; return st * 1024 + (ob ^ (((ob >> 9) & 1) << 5)); }
DI void stage_rc(int b, int& R, int& C) { const int st = b / 1024, sb = b % 1024, swz = sb ^ (((sb >> 9) & 1) << 5); R = (st >> 1) * 16 + swz / 64; C = (st & 1) * 32 + (swz % 64) / 2; }
DI int perm32(int rho) { const int n = rho >> 4, i = rho & 15; return 8 * (i >> 2) + 4 * n + (i & 3); }
struct Unit { int pm, pn, kt0, ntk, kp, slot; };
struct Gemm { const bf16_t* A; const bf16_t* Bt; int M, N, K; };
DI void map_unit(int wgid, int nM, int nN, int nwg, int& pm, int& pn) {
    { const int q = nwg / NXCD, r = nwg % NXCD, xcd = wgid % NXCD, off = wgid / NXCD; wgid = (xcd < r ? xcd * (q + 1) : r * (q + 1) + (xcd - r) * q) + off; }
    const int nig = WGM * nN, gid = wgid / nig, fm = gid * WGM, gsz = (nM - fm) < WGM ? (nM - fm) : WGM;
    pm = fm + ((wgid % nig) % gsz); pn = (wgid % nig) / gsz;
}
struct StaticOrder {
    int nM, nN, nwg, G, c, nt, nsplit, nfull;
    DI void init(int M, int N, int K, int G_, int c_, int nsplit_) { nM = M / BM; nN = N / BM; nwg = nM * nN; G = G_; c = c_; nt = K / BK; nsplit = nsplit_; nfull = nsplit_ ? (nwg / G_) * G_ : nwg; }
    DI bool next(int i, Unit& u) const {
        const long L = (long)i * G + c; int uidx;
        if (L < nfull) { uidx = (int)L; u.kp = -1; u.slot = 0; u.kt0 = 0; u.ntk = nt; }
        else { const long q = L - nfull; if (q >= (long)(nwg - nfull) * nsplit) return false;
            u.slot = (int)(q / nsplit); u.kp = (int)(q % nsplit); uidx = nfull + u.slot;
            const int base = (nt / nsplit) & ~1, half_extra = (nt - base * nsplit) >> 1;
            u.ntk = base + (u.kp < half_extra ? 2 : 0); u.kt0 = u.kp * base + 2 * (u.kp < half_extra ? u.kp : half_extra); }
        map_unit(uidx, nM, nN, nwg, u.pm, u.pn); return true;
    }
};
template <class Epi>
DI void gemm_phase(const Ctx cx, LAS unsigned char* lds, const Gemm g, const StaticOrder& S, const Epi& E) {
    const int tid = cx.tid, wid = __builtin_amdgcn_readfirstlane(tid >> 6), lane = tid & 63, wr = wid >> 2, wc = wid & 3, fr = lane & 15, fq = lane >> 4;
    const int K = g.K;
    unsigned voffA[2], voffB[2];
#pragma unroll
    for (int i = 0; i < 2; ++i) { int R, C; stage_rc(tid * 16 + i * 8192, R, C); const int Rb = Epi::PERM ? ((R & ~31) + perm32(R & 31)) : R;
        voffA[i] = (unsigned)(R * K + C) * 2u; voffB[i] = (unsigned)(Rb * K + C) * 2u; }
    const size_t kstep = (size_t)(BK * 2);
    const size_t hstep = (size_t)HALF * K * 2;
    const size_t tstep = 2 * hstep;
    const unsigned ldsw = (unsigned)wid * 1024u;
    const int aoff = lds_byte(wr * 64 + fr, fq * 8), boff = lds_byte(wc * 32 + fr, fq * 8);
#define PG8_SA(b, h) (((b) * 2 + (h)) * HTB)
#define PG8_SB(b, h) ((4 + (b) * 2 + (h)) * HTB)
#define PG8_STAGE(bufoff, gbase, voff) do { _Pragma("unroll") for (int _i = 0; _i < 2; ++_i) \
        __builtin_amdgcn_global_load_lds((const unsigned*)((const char*)(gbase) + (voff)[_i]), (LAS unsigned*)(lds + (bufoff) + ldsw + _i * 8192), 16, 0, 0); } while (0)
#define PG8_LDA(dst, b, h) do { _Pragma("unroll") for (int m = 0; m < 4; ++m) _Pragma("unroll") for (int k = 0; k < 2; ++k) dst[m][k] = *(const LAS bf16x8*)(lds + PG8_SA(b, h) + aoff + m * 2048 + k * 1024); } while (0)
#define PG8_LDB(dst, b, h) do { _Pragma("unroll") for (int n = 0; n < 2; ++n) _Pragma("unroll") for (int k = 0; k < 2; ++k) dst[n][k] = *(const LAS bf16x8*)(lds + PG8_SB(b, h) + boff + n * 2048 + k * 1024); } while (0)
#define PG8_MMA(ai, bj, At, Bt) do { __builtin_amdgcn_s_setprio(1); _Pragma("unroll") for (int m = 0; m < 4; ++m) _Pragma("unroll") for (int n = 0; n < 2; ++n) _Pragma("unroll") for (int k = 0; k < 2; ++k) \
        acc[ai][bj][m][n] = __builtin_amdgcn_mfma_f32_16x16x32_bf16(Bt[n][k], At[m][k], acc[ai][bj][m][n], 0, 0, 0); __builtin_amdgcn_s_setprio(0); } while (0)
#define PG8_WAIT_V(n) asm volatile("s_waitcnt vmcnt(" #n ")" ::: "memory")
#define PG8_WAIT_L(n) asm volatile("s_waitcnt lgkmcnt(" #n ")" ::: "memory")
#define PG8_BAR __builtin_amdgcn_s_barrier()
#define PG8_SCHED __builtin_amdgcn_sched_barrier(0)
    Unit cur, nxt; int ui = 0;
    if (!S.next(0, cur)) return;
    f32x4 acc[2][2][4][2];
#pragma unroll
    for (int a = 0; a < 2; ++a)
#pragma unroll
        for (int b = 0; b < 2; ++b)
#pragma unroll
            for (int m = 0; m < 4; ++m)
#pragma unroll
                for (int n = 0; n < 2; ++n) acc[a][b][m][n] = (f32x4){0.f, 0.f, 0.f, 0.f};
    bf16x8 At[4][2], B0[2][2], B1[2][2];
    const char* cA = (const char*)g.A + (size_t)cur.pm * tstep + (size_t)cur.kt0 * kstep; const char* cB = (const char*)g.Bt + (size_t)cur.pn * tstep + (size_t)cur.kt0 * kstep;
    PG8_STAGE(PG8_SB(0, 0), cB, voffB); PG8_STAGE(PG8_SA(0, 0), cA, voffA); PG8_STAGE(PG8_SB(0, 1), cB + hstep, voffB); PG8_STAGE(PG8_SA(0, 1), cA + hstep, voffA);
    if (wr == 1) PG8_BAR;
    PG8_WAIT_V(4); PG8_BAR;
    PG8_STAGE(PG8_SB(1, 0), cB + kstep, voffB); PG8_STAGE(PG8_SA(1, 0), cA + kstep, voffA); PG8_STAGE(PG8_SB(1, 1), cB + hstep + kstep, voffB);
    PG8_WAIT_V(6); PG8_BAR;
    for (;;) {
        const bool has_next = S.next(ui + 1, nxt);
        const char* nA = has_next ? (const char*)g.A + (size_t)nxt.pm * tstep + (size_t)nxt.kt0 * kstep : cA; const char* nB = has_next ? (const char*)g.Bt + (size_t)nxt.pn * tstep + (size_t)nxt.kt0 * kstep : cB;
        const int nt = cur.ntk;
        for (int t = 0; t < nt; t += 2) {
            const bool last = (t == nt - 2);
            const char* a1 = cA + (size_t)(t + 1) * kstep;
            const char* a2 = last ? nA : cA + (size_t)(t + 2) * kstep; const char* b2 = last ? nB : cB + (size_t)(t + 2) * kstep;
            const char* a3 = a2 + kstep; const char* b3 = b2 + kstep;
            PG8_LDB(B0, 0, 0); PG8_SCHED; PG8_LDA(At, 0, 0); PG8_STAGE(PG8_SA(1, 1), a1 + hstep, voffA);
            PG8_WAIT_L(8); PG8_BAR; PG8_WAIT_L(0); PG8_MMA(0, 0, At, B0); PG8_BAR; PG8_SCHED;
            PG8_LDB(B1, 0, 1); PG8_STAGE(PG8_SB(0, 0), b2, voffB);
            PG8_BAR; PG8_WAIT_L(0); PG8_MMA(0, 1, At, B1); PG8_BAR;
            PG8_LDA(At, 0, 1); PG8_STAGE(PG8_SA(0, 0), a2, voffA);
            PG8_BAR; PG8_WAIT_L(0); PG8_MMA(1, 0, At, B0); PG8_BAR; PG8_SCHED;
            PG8_STAGE(PG8_SB(0, 1), b2 + hstep, voffB);
            PG8_WAIT_V(6); PG8_BAR; PG8_MMA(1, 1, At, B1); PG8_BAR;
            PG8_LDB(B0, 1, 0); PG8_SCHED; PG8_LDA(At, 1, 0); PG8_STAGE(PG8_SA(0, 1), a2 + hstep, voffA);
            PG8_WAIT_L(8); PG8_BAR; PG8_WAIT_L(0); PG8_MMA(0, 0, At, B0); PG8_BAR; PG8_SCHED;
            PG8_LDB(B1, 1, 1); PG8_STAGE(PG8_SB(1, 0), b3, voffB);
            PG8_BAR; PG8_WAIT_L(0); PG8_MMA(0, 1, At, B1); PG8_BAR;
            PG8_LDA(At, 1, 1); PG8_STAGE(PG8_SA(1, 0), a3, voffA);
            PG8_BAR; PG8_WAIT_L(0); PG8_MMA(1, 0, At, B0); PG8_BAR; PG8_SCHED;
            PG8_STAGE(PG8_SB(1, 1), b3 + hstep, voffB);
            PG8_WAIT_V(6); PG8_BAR; PG8_MMA(1, 1, At, B1); PG8_BAR;
        }
        E(acc, cur, wr, wc, fr, fq);
        if (!has_next) break;
#pragma unroll
        for (int a = 0; a < 2; ++a)
#pragma unroll
            for (int b = 0; b < 2; ++b)
#pragma unroll
                for (int m = 0; m < 4; ++m)
#pragma unroll
                    for (int n = 0; n < 2; ++n) acc[a][b][m][n] = (f32x4){0.f, 0.f, 0.f, 0.f};
        cur = nxt; cA = nA; cB = nB; ++ui;
    }
    PG8_WAIT_V(0);
    if (wr == 0) PG8_BAR;
    PG8_BAR;
#undef PG8_SA
#undef PG8_SB
#undef PG8_STAGE
#undef PG8_LDA
#undef PG8_LDB
#undef PG8_MMA
#undef PG8_WAIT_V
#undef PG8_WAIT_L
#undef PG8_BAR
#undef PG8_SCHED
}
}
using pg8::Unit;
typedef const f32x4 (&AccRef)[2][2][4][2];

DI u32x4 pack8(f32x4 v0, f32x4 v1) { u32x4 w; w.x = pk2(v0[0], v0[1]); w.y = pk2(v0[2], v0[3]); w.z = pk2(v1[0], v1[1]); w.w = pk2(v1[2], v1[3]); return w; }
DI void unpack8(u32x4 w, f32x4& a, f32x4& b) {
    a[0] = __uint_as_float(w.x << 16); a[1] = __uint_as_float(w.x & 0xffff0000u); a[2] = __uint_as_float(w.y << 16); a[3] = __uint_as_float(w.y & 0xffff0000u);
    b[0] = __uint_as_float(w.z << 16); b[1] = __uint_as_float(w.z & 0xffff0000u); b[2] = __uint_as_float(w.w << 16); b[3] = __uint_as_float(w.w & 0xffff0000u);
}

struct EpiInproj {
    static constexpr bool PERM = true;
    bf16_t* P; float* fz;
    DI void operator()(AccRef acc, const Unit& u, int wr, int wc, int fr, int fq) const {
        const int row0 = u.pm * 256 + wr * 64 + fr, col0 = u.pn * 256 + wc * 32 + 8 * fq;
        const bool isf = (u.pn >= 4 && u.pn < 8);
#pragma unroll
        for (int ai = 0; ai < 2; ++ai)
#pragma unroll
            for (int m = 0; m < 4; ++m) { const size_t row = (size_t)(row0 + ai * 128 + m * 16);
#pragma unroll
                for (int bj = 0; bj < 2; ++bj) { const int c = col0 + bj * 128;
                    if (isf) { float* d = fz + row * DH + (c - 1024); *(f32x4*)d = acc[ai][bj][m][0]; *(f32x4*)(d + 4) = acc[ai][bj][m][1]; }
                    else *(u32x4*)(P + row * INC + c) = pack8(acc[ai][bj][m][0], acc[ai][bj][m][1]); } }
    }
};
struct EpiGlu {
    static constexpr bool PERM = true;
    const bf16_t* ys; bf16_t* os; const float* bias;
    DI void operator()(AccRef acc, const Unit& u, int wr, int wc, int fr, int fq) const {
        const int row0 = u.pm * 256 + wr * 64 + fr, col0 = u.pn * 256 + wc * 32 + 8 * fq;
#pragma unroll
        for (int bj = 0; bj < 2; ++bj) { const int c = col0 + bj * 128; const f32x4 b0 = *(const f32x4*)(bias + c), b1 = *(const f32x4*)(bias + c + 4);
#pragma unroll
            for (int ai = 0; ai < 2; ++ai)
#pragma unroll
                for (int m = 0; m < 4; ++m) { const size_t off = (size_t)(row0 + ai * 128 + m * 16) * DH + c;
                    f32x4 y0, y1; unpack8(*(const u32x4*)(ys + off), y0, y1);
                    f32x4 v0 = acc[ai][bj][m][0] + b0, v1 = acc[ai][bj][m][1] + b1;
#pragma unroll
                    for (int j = 0; j < 4; ++j) { v0[j] = y0[j] * sigmoidf_(v0[j]); v1[j] = y1[j] * sigmoidf_(v1[j]); }
                    *(u32x4*)(os + off) = pack8(v0, v1); } }
    }
};
template <bool ADD> struct EpiMix {
    static constexpr bool PERM = true;
    const bf16_t* P; int gcol; bf16_t* mix;
    DI void operator()(AccRef acc, const Unit& u, int wr, int wc, int fr, int fq) const {
        const int row0 = u.pm * 256 + wr * 64 + fr, col0 = u.pn * 256 + wc * 32 + 8 * fq;
#pragma unroll
        for (int ai = 0; ai < 2; ++ai)
#pragma unroll
            for (int m = 0; m < 4; ++m) { const size_t row = (size_t)(row0 + ai * 128 + m * 16);
#pragma unroll
                for (int bj = 0; bj < 2; ++bj) { const int c = col0 + bj * 128;
                    f32x4 g0, g1; unpack8(*(const u32x4*)(P + row * INC + gcol + c), g0, g1);
                    f32x4 v0, v1;
#pragma unroll
                    for (int j = 0; j < 4; ++j) { v0[j] = sigmoidf_(g0[j]) * acc[ai][bj][m][0][j]; v1[j] = sigmoidf_(g1[j]) * acc[ai][bj][m][1][j]; }
                    if (ADD) { f32x4 p0, p1; unpack8(*(const u32x4*)(mix + row * DM + c), p0, p1); v0 += p0; v1 += p1; }
                    *(u32x4*)(mix + row * DM + c) = pack8(v0, v1); } }
    }
};
struct EpiResid {
    static constexpr bool PERM = false;
    const float* xp; const float* xs; float* xout; float* part;
    DI void operator()(AccRef acc, const Unit& u, int wr, int wc, int fr, int fq) const {
        if (u.kp >= 0) {
            bf16_t* slab = (bf16_t*)part + ((size_t)(u.slot * 8 + u.kp) << 16) + (size_t)(wr * 64 + fr) * 256 + wc * 32 + 4 * fq;
#pragma unroll
            for (int ai = 0; ai < 2; ++ai)
#pragma unroll
                for (int m = 0; m < 4; ++m)
#pragma unroll
                    for (int bj = 0; bj < 2; ++bj)
#pragma unroll
                        for (int n = 0; n < 2; ++n) { const f32x4 a = acc[ai][bj][m][n]; u32x2 q; q.x = pk2(a[0], a[1]); q.y = pk2(a[2], a[3]);
                            *(u32x2*)(slab + (size_t)(ai * 128 + m * 16) * 256 + bj * 128 + n * 16) = q; }
            return; }
        const int row0 = u.pm * 256 + wr * 64 + fr, col0 = u.pn * 256 + wc * 32 + 4 * fq;
#pragma unroll
        for (int ai = 0; ai < 2; ++ai)
#pragma unroll
            for (int m = 0; m < 4; ++m) { const int row = row0 + ai * 128 + m * 16;
                const float* src = (row < TP) ? xp + (size_t)row * DM : xs + (size_t)(row - TP) * DM; float* dst = xout + (size_t)row * DM;
#pragma unroll
                for (int bj = 0; bj < 2; ++bj)
#pragma unroll
                    for (int n = 0; n < 2; ++n) { const int c = col0 + bj * 128 + n * 16; *(f32x4*)(dst + c) = *(const f32x4*)(src + c) + acc[ai][bj][m][n]; } }
    }
};
struct EpiSwiglu {
    static constexpr bool PERM = true;
    bf16_t* hid;
    DI void operator()(AccRef acc, const Unit& u, int wr, int wc, int fr, int fq) const {
        const int row0 = u.pm * 256 + wr * 64 + fr, col0 = u.pn * 128 + wc * 32 + 8 * fq;
#pragma unroll
        for (int ai = 0; ai < 2; ++ai)
#pragma unroll
            for (int m = 0; m < 4; ++m) { const size_t row = (size_t)(row0 + ai * 128 + m * 16);
                f32x4 v0, v1;
#pragma unroll
                for (int j = 0; j < 4; ++j) { const float a = acc[ai][0][m][0][j], b = acc[ai][0][m][1][j];
                    v0[j] = a * sigmoidf_(a) * acc[ai][1][m][0][j]; v1[j] = b * sigmoidf_(b) * acc[ai][1][m][1][j]; }
                *(u32x4*)(hid + row * DFF + col0) = pack8(v0, v1); }
    }
};

DI void transpose_item(const float* W, int K, int N, bf16_t* WT, int kb, int n0, int dst_row0, LAS float* scr, int lane) {
    const int k0 = 64 * kb;
    float wv[32];
#pragma unroll
    for (int i = 0; i < 32; ++i) wv[i] = W[(size_t)(k0 + 2 * i + (lane >> 5)) * N + n0 + (lane & 31)];
#pragma unroll
    for (int i = 0; i < 32; ++i) scr[(2 * i + (lane >> 5)) * 33 + (lane & 31)] = wv[i];
    __syncthreads();
    const int c = lane & 7;
#pragma unroll
    for (int j = 0; j < 4; ++j) { const int n = (lane >> 3) + 8 * j; const LAS float* s = scr + (8 * c) * 33 + n;
        u32x4 o; o.x = pk2(s[0 * 33], s[1 * 33]); o.y = pk2(s[2 * 33], s[3 * 33]); o.z = pk2(s[4 * 33], s[5 * 33]); o.w = pk2(s[6 * 33], s[7 * 33]);
        *(u32x4*)(WT + (size_t)(dst_row0 + n) * K + k0 + 8 * c) = o; }
    __syncthreads();
}
DI void phase_convert(const Ctx cx, const Params& p, int l, LAS unsigned char* lds) {
    const int tid = cx.tid, lane = tid & 63, w = tid >> 6;
    LAS float* scr = (LAS float*)(lds + w * 16384);
    const int gw = cx.bid * 8 + w, NGW = cx.nb * 8;
    constexpr int I_IN = (DM / 64) * (INC / 32), I_GLU = (DH / 64) * (DH / 32), I_BH = (DH / 64) * (DM / 32), I_OUT = (DM / 64) * (DM / 32), I_GU = (DM / 64) * (2 * DFF / 32), I_DN = (DFF / 64) * (DM / 32);
    constexpr int NITEMS = I_IN + I_GLU + 2 * I_BH + I_OUT + I_GU + I_DN;
    for (int it = gw; it < NITEMS; it += NGW) {
        int r = it;
        if (r < I_IN) { const int nb = INC / 32; transpose_item(p.in[7] + (size_t)l * DM * INC, DM, INC, (bf16_t*)(p.ws + WS_WIN), r / nb, 32 * (r % nb), 32 * (r % nb), scr, lane); continue; } r -= I_IN;
        if (r < I_GLU) { const int nb = DH / 32; transpose_item(p.in[18] + (size_t)l * DH * DH, DH, DH, (bf16_t*)(p.ws + WS_WGLU), r / nb, 32 * (r % nb), 32 * (r % nb), scr, lane); continue; } r -= I_GLU;
        if (r < I_BH) { const int nb = DM / 32; transpose_item(p.in[9] + (size_t)l * DH * DM, DH, DM, (bf16_t*)(p.ws + WS_WBH), r / nb, 32 * (r % nb), 32 * (r % nb), scr, lane); continue; } r -= I_BH;
        if (r < I_BH) { const int nb = DM / 32; transpose_item(p.in[20] + (size_t)l * DH * DM, DH, DM, (bf16_t*)(p.ws + WS_WBS), r / nb, 32 * (r % nb), 32 * (r % nb), scr, lane); continue; } r -= I_BH;
        if (r < I_OUT) { const int nb = DM / 32; transpose_item(p.in[21] + (size_t)l * DM * DM, DM, DM, (bf16_t*)(p.ws + WS_WOUT), r / nb, 32 * (r % nb), 32 * (r % nb), scr, lane); continue; } r -= I_OUT;
        if (r < I_GU) { const int nb = 2 * DFF / 32; const int n0 = 32 * (r % nb); const int jn = n0 < DFF ? n0 : n0 - DFF; const int dst = 256 * (jn / 128) + (n0 < DFF ? 0 : 128) + (jn % 128);
            transpose_item(p.in[23] + (size_t)l * DM * 2 * DFF, DM, 2 * DFF, (bf16_t*)(p.ws + WS_WGU), r / nb, n0, dst, scr, lane); continue; } r -= I_GU;
        { const int nb = DM / 32; transpose_item(p.in[24] + (size_t)l * DFF * DM, DFF, DM, (bf16_t*)(p.ws + WS_WDN), r / nb, 32 * (r % nb), 32 * (r % nb), scr, lane); }
    }
    const int gt = cx.bid * 512 + tid;
    if (gt < 4096) {
        const int g = gt >> 6, n = gt & 63;
        const float alr = p.in[10][l * 4096 + gt], aim = p.in[11][l * 4096 + gt], dt = expf(p.in[12][l * 64 + g]);
        const float lr = -expf(alr), li = aim, ar = lr * dt, ai = li * dt;
        const float er = expf(ar), cr = cosf(ai), sr = sinf(ai), sh = sinf(0.5f * ai);
        const float lbr = er * cr, lbi = er * sr;
        const float nr = expm1f(ar) * cr - 2.0f * sh * sh, ni = lbi;
        const float den = lr * lr + li * li, zr = (nr * lr + ni * li) / den, zi = (ni * lr - nr * li) / den;
        bf16_t* BmT = (bf16_t*)(p.ws + WS_BMT) + (size_t)g * 128 * 16; bf16_t* CmT = (bf16_t*)(p.ws + WS_CMT) + (size_t)g * 16 * 128;
        const float* bre = p.in[13] + ((size_t)(l * 64 + g) * 64 + n) * 16; const float* bim = p.in[14] + ((size_t)(l * 64 + g) * 64 + n) * 16;
#pragma unroll
        for (int q = 0; q < 16; ++q) { const float br = bre[q], bi = bim[q]; BmT[n * 16 + q] = f2bf(zr * br - zi * bi); BmT[(64 + n) * 16 + q] = f2bf(zr * bi + zi * br); }
        const float* cre = p.in[15] + (size_t)(l * 64 + g) * 16 * 64 + n; const float* cim = p.in[16] + (size_t)(l * 64 + g) * 16 * 64 + n;
#pragma unroll
        for (int q = 0; q < 16; ++q) { CmT[q * 128 + n] = f2bf(cre[q * 64]); CmT[q * 128 + 64 + n] = f2bf(-cim[q * 64]); }
        float* lamb = (float*)(p.ws + WS_LAMB) + g * 128; float* laml = (float*)(p.ws + WS_LAML) + g * 128;
        lamb[n] = lbr; lamb[64 + n] = lbi;
        float pr = lbr, pi = lbi;
#pragma unroll
        for (int s = 0; s < 8; ++s) { const float t = pr * pr - pi * pi; pi = 2.0f * pr * pi; pr = t; }
        laml[n] = pr; laml[64 + n] = pi;
    }
}
template <bool TO_BF16, bool FIX> DI void phase_rmsnorm(const Ctx cx, const float* xp, const float* xs, const float* w, bf16_t* ob, float* of,
                                                         const float* part, const float* bp, const float* bs, float* xfix, LAS unsigned char* lds) {
    const int lane = cx.tid & 63, gw = cx.bid * 8 + (cx.tid >> 6), NGW = cx.nb * 8;
    LAS unsigned char* smap = lds;
    if (FIX) {
        for (int i = cx.tid; i < 68 * 8; i += 512) smap[i] = 0;
        __syncthreads();
        if (cx.tid < 32 && cx.nb == 256) { int pm, pn; pg8::map_unit(512 + cx.tid, T / 256, DM / 256, (T / 256) * (DM / 256), pm, pn); smap[pm * 8 + pn] = (unsigned char)(cx.tid + 1); }
        __syncthreads();
    }
    for (int row = gw; row < T; row += NGW) {
        const float* src = (row < TP) ? xp + (size_t)row * DM : xs + (size_t)(row - TP) * DM;
        f32x4 v[8]; float s = 0.f;
#pragma unroll
        for (int j = 0; j < 8; ++j) v[j] = ((const f32x4*)src)[lane + 64 * j];
        if (FIX) {
            const float* bsrc = (row < TP) ? bp + (size_t)row * DM : bs + (size_t)(row - TP) * DM;
#pragma unroll
            for (int j = 0; j < 8; ++j) { const int sj = smap[(row >> 8) * 8 + j];
                if (sj) { f32x4 a = ((const f32x4*)bsrc)[lane + 64 * j]; const bf16_t* pp = (const bf16_t*)part + ((size_t)((sj - 1) * 8) << 16) + (size_t)(row & 255) * 256 + 4 * lane;
#pragma unroll
                    for (int kp = 0; kp < 8; ++kp) { const u32x2 q = *(const u32x2*)(pp + ((size_t)kp << 16));
                        a[0] += __uint_as_float(q.x << 16); a[1] += __uint_as_float(q.x & 0xffff0000u); a[2] += __uint_as_float(q.y << 16); a[3] += __uint_as_float(q.y & 0xffff0000u); }
                    v[j] = a; ((f32x4*)(xfix + (size_t)row * DM))[lane + 64 * j] = a; } }
        }
#pragma unroll
        for (int j = 0; j < 8; ++j) s += (v[j][0] * v[j][0] + v[j][1] * v[j][1]) + (v[j][2] * v[j][2] + v[j][3] * v[j][3]);
        const float r = 1.0f / sqrtf(wave_sum(s) * (1.0f / DM) + 1e-6f);
#pragma unroll
        for (int j = 0; j < 8; ++j) { const f32x4 wv = ((const f32x4*)w)[lane + 64 * j]; const f32x4 o = v[j] * r * wv;
            if (TO_BF16) { u32x2 q; q.x = pk2(o[0], o[1]); q.y = pk2(o[2], o[3]); ((u32x2*)(ob + (size_t)row * DM))[lane + 64 * j] = q; }
            else ((f32x4*)(of + (size_t)row * DM))[lane + 64 * j] = o; }
    }
}

template <bool OUT>
DI void hgrn_item(const Ctx cx, const Params& p, int l, int h, int row0, int nmacro, int nsub, const float* Sinit, float* Sout, float* Dout, LAS unsigned char* lds) {
    const int tid = cx.tid, lane = tid & 63, w = tid >> 6, l15 = lane & 15, quad = lane >> 4;
    LAS bf16_t* qt = (LAS bf16_t*)lds;
    LAS bf16_t* kt = qt + 64 * 136;
    LAS bf16_t* keT = kt + 64 * 136;
    LAS bf16_t* vT = keT + 128 * 72;
    LAS float* Dl = (LAS float*)(vT + 128 * 72);
    LAS float* Ll = Dl + 512;
    LAS float* ob = Ll + 512;
    const bf16_t* P = (const bf16_t*)(p.ws + WS_P);
    const float* fz = (const float*)(p.ws + WS_FZ);
    bf16_t* oh = (bf16_t*)(p.ws + WS_OH);
    f32x4 S[8];
#pragma unroll
    for (int i = 0; i < 8; ++i)
#pragma unroll
        for (int r = 0; r < 4; ++r) S[i][r] = Sinit ? Sinit[(size_t)(16 * i + quad * 4 + r) * 128 + 16 * w + l15] : 0.f;
    const int sj = tid >> 7, sc = tid & 127, scol = h * 128 + sc;
    float lb = 0.f;
    if (l == 1) { const float l0 = p.in[5][scol], l1 = p.in[5][DH + scol]; lb = 1.0f / (1.0f + expf(l0 - l1)); }
    const float oml = 1.0f - lb;
    float totlog = 0.f;
    float zc[16]; bf16_t qc[16], ic[16];
    if (sj < nsub) {
#pragma unroll
        for (int i = 0; i < 16; ++i) { const size_t r = (size_t)row0 + 16 * sj + i; zc[i] = fz[r * DH + scol]; ic[i] = P[r * INC + C_I + scol]; qc[i] = OUT ? P[r * INC + C_Q + scol] : (bf16_t)0; }
    }
    for (int mc = 0; mc < nmacro; ++mc) {
        lds_barrier();
        if (sj < nsub) {
            float bl[16], kv[16]; float run = 0.f;
#pragma unroll
            for (int i = 0; i < 16; ++i) {
                const float z = zc[i];
                const float e = __expf(-fabsf(z)), rc = 1.0f / (1.0f + e);
                const float lsig = fminf(z, 0.f) - __logf(1.0f + e);
                const float sig = z >= 0.f ? rc : e * rc, nsig = z >= 0.f ? e * rc : rc;
                const float lf = (l == 0) ? lsig : __logf(lb + oml * sig);
                kv[i] = oml * nsig; run += lf; bl[i] = run;
            }
            unsigned kp[8], vp[8];
#pragma unroll
            for (int i = 0; i < 16; i += 2) {
                float ke[2], vv[2];
#pragma unroll
                for (int d = 0; d < 2; ++d) {
                    const float iv = bf2f(ic[i + d]);
                    if (OUT) { const float q = bf2f(qc[i + d]);
                        qt[(16 * sj + i + d) * 136 + sc] = f2bf(q * __expf(bl[i + d]));
                        kt[(16 * sj + i + d) * 136 + sc] = f2bf(kv[i + d] * __expf(fminf(-bl[i + d], 80.f))); }
                    ke[d] = kv[i + d] * __expf(run - bl[i + d]);
                    vv[d] = iv * sigmoidf_(iv);
                }
                kp[i >> 1] = pk2(ke[0], ke[1]); vp[i >> 1] = pk2(vv[0], vv[1]);
            }
            *(LAS u32x4*)(keT + sc * 72 + 16 * sj) = (u32x4){kp[0], kp[1], kp[2], kp[3]}; *(LAS u32x4*)(keT + sc * 72 + 16 * sj + 8) = (u32x4){kp[4], kp[5], kp[6], kp[7]};
            *(LAS u32x4*)(vT + sc * 72 + 16 * sj) = (u32x4){vp[0], vp[1], vp[2], vp[3]}; *(LAS u32x4*)(vT + sc * 72 + 16 * sj + 8) = (u32x4){vp[4], vp[5], vp[6], vp[7]};
            Dl[sj * 128 + sc] = __expf(run); Ll[sj * 128 + sc] = run;
            if (mc + 1 < nmacro) {
#pragma unroll
                for (int i = 0; i < 16; ++i) { const size_t r = (size_t)row0 + (size_t)(mc + 1) * 64 + 16 * sj + i; zc[i] = fz[r * DH + scol]; ic[i] = P[r * INC + C_I + scol]; qc[i] = OUT ? P[r * INC + C_Q + scol] : (bf16_t)0; }
            }
        }
        lds_barrier();
        if (tid < 128) { for (int j = 0; j < nsub; ++j) totlog += Ll[j * 128 + tid]; }
#pragma unroll 1
        for (int j = 0; j < nsub; ++j) {
            const bf16x4 v4 = *(const LAS bf16x4*)(vT + (16 * w + l15) * 72 + 16 * j + quad * 4);
            const bf16x8 vB = mk8(v4, (bf16x4){0, 0, 0, 0});
            if (OUT) {
                f32x4 oacc = {0.f, 0.f, 0.f, 0.f};
#pragma unroll
                for (int kk = 0; kk < 4; ++kk) {
                    const bf16x8 bS = mk8u(pk2(S[2 * kk][0], S[2 * kk][1]), pk2(S[2 * kk][2], S[2 * kk][3]), pk2(S[2 * kk + 1][0], S[2 * kk + 1][1]), pk2(S[2 * kk + 1][2], S[2 * kk + 1][3]));
                    const bf16x4 a0 = *(const LAS bf16x4*)(qt + (16 * j + l15) * 136 + 32 * kk + quad * 4);
                    const bf16x4 a1 = *(const LAS bf16x4*)(qt + (16 * j + l15) * 136 + 32 * kk + 16 + quad * 4);
                    oacc = MFMA16(mk8(a0, a1), bS, oacc);
                }
                f32x4 pt = {0.f, 0.f, 0.f, 0.f};
#pragma unroll
                for (int kk = 0; kk < 4; ++kk) {
                    const bf16x8 aK = *(const LAS bf16x8*)(kt + (16 * j + l15) * 136 + 32 * kk + quad * 8);
                    const bf16x8 bQ = *(const LAS bf16x8*)(qt + (16 * j + l15) * 136 + 32 * kk + quad * 8);
                    pt = MFMA16(aK, bQ, pt);
                }
#pragma unroll
                for (int r = 0; r < 4; ++r) if (quad * 4 + r > l15) pt[r] = 0.f;
                const bf16x8 aP = mk8u(pk2(pt[0], pt[1]), pk2(pt[2], pt[3]), 0u, 0u);
                oacc = MFMA16(aP, vB, oacc);
#pragma unroll
                for (int r = 0; r < 4; ++r) ob[(16 * j + quad * 4 + r) * 132 + 16 * w + l15] = oacc[r];
            }
#pragma unroll
            for (int i = 0; i < 8; ++i) {
                const f32x4 d = *(const LAS f32x4*)(Dl + j * 128 + 16 * i + quad * 4);
                const bf16x4 k4 = *(const LAS bf16x4*)(keT + (16 * i + l15) * 72 + 16 * j + quad * 4);
                S[i] = MFMA16(mk8(k4, (bf16x4){0, 0, 0, 0}), vB, S[i] * d);
            }
        }
        if (OUT) {
            lds_barrier();
            const int t = tid >> 3, c8 = tid & 7;
            if (t < nsub * 16) {
                f32x4 ov[4]; float s = 0.f;
#pragma unroll
                for (int q = 0; q < 4; ++q) { ov[q] = *(const LAS f32x4*)(ob + t * 132 + 16 * c8 + 4 * q); s += (ov[q][0] * ov[q][0] + ov[q][1] * ov[q][1]) + (ov[q][2] * ov[q][2] + ov[q][3] * ov[q][3]); }
                s += __shfl_xor(s, 1); s += __shfl_xor(s, 2); s += __shfl_xor(s, 4);
                const float rs = 1.0f / sqrtf(s * (1.0f / 128.0f) + 1e-6f);
                const size_t row = (size_t)row0 + (size_t)mc * 64 + t; const int colg = h * 128 + 16 * c8;
                const float* gn = p.in[8] + l * DH + colg;
#pragma unroll
                for (int hf = 0; hf < 2; ++hf) {
                    f32x4 g0, g1; unpack8(*(const u32x4*)(P + row * INC + C_G + colg + 8 * hf), g0, g1);
                    const f32x4 n0 = *(const f32x4*)(gn + 8 * hf), n1 = *(const f32x4*)(gn + 8 * hf + 4);
                    f32x4 r0, r1;
#pragma unroll
                    for (int q = 0; q < 4; ++q) { r0[q] = ov[2 * hf][q] * rs * n0[q] * g0[q] * sigmoidf_(g0[q]); r1[q] = ov[2 * hf + 1][q] * rs * n1[q] * g1[q] * sigmoidf_(g1[q]); }
                    *(u32x4*)(oh + row * DH + colg + 8 * hf) = pack8(r0, r1);
                }
            }
        }
    }
    if (Sout) {
#pragma unroll
        for (int i = 0; i < 8; ++i)
#pragma unroll
            for (int r = 0; r < 4; ++r) Sout[(size_t)(16 * i + quad * 4 + r) * 128 + 16 * w + l15] = S[i][r];
    }
    if (Dout && tid < 128) Dout[tid] = __expf(totlog);
}

template <bool OUT>
DI void s5_task(const Ctx cx, const Params& p, int l, int g, int row0, int ntiles, float& xr, float& xi, LAS unsigned char* wl) {
    const int lane = cx.tid & 63, l15 = lane & 15, quad = lane >> 4;
    const bf16_t* P = (const bf16_t*)(p.ws + WS_P);
    const bf16_t* BmT = (const bf16_t*)(p.ws + WS_BMT) + (size_t)g * 128 * 16; const bf16_t* CmT = (const bf16_t*)(p.ws + WS_CMT) + (size_t)g * 16 * 128;
    const float* lamb = (const float*)(p.ws + WS_LAMB) + g * 128;
    bf16_t* ys = (bf16_t*)(p.ws + WS_YS);
    const float lam_r = lamb[lane], lam_i = lamb[64 + lane];
    const bf16x8 zero8 = {0, 0, 0, 0, 0, 0, 0, 0};
    bf16x8 bB[8], bC[4];
#pragma unroll
    for (int t = 0; t < 8; ++t) bB[t] = quad < 2 ? *(const bf16x8*)(BmT + (16 * t + l15) * 16 + quad * 8) : zero8;
#pragma unroll
    for (int kk = 0; kk < 4; ++kk) bC[kk] = OUT ? *(const bf16x8*)(CmT + l15 * 128 + 32 * kk + quad * 8) : zero8;
    const float dsk = p.in[17][l * DH + g * 16 + l15];
    LAS float* bu = (LAS float*)wl;
    LAS bf16_t* xs = (LAS bf16_t*)(wl + 8448);
    const bf16_t* pu = P + (size_t)row0 * INC + C_U + g * 16;
    bf16x8 aUn = quad < 2 ? *(const bf16x8*)(pu + (size_t)l15 * INC + quad * 8) : zero8;
    bf16_t uvn[4];
#pragma unroll
    for (int r = 0; r < 4; ++r) uvn[r] = OUT ? pu[(size_t)(quad * 4 + r) * INC + l15] : (bf16_t)0;
#pragma unroll 1
    for (int t0 = 0; t0 < ntiles; ++t0) {
        const size_t rowb = (size_t)row0 + 16 * t0;
        const bf16x8 aU = aUn; bf16_t uvc[4];
#pragma unroll
        for (int r = 0; r < 4; ++r) uvc[r] = uvn[r];
        if (t0 + 1 < ntiles) {
            const bf16_t* pn = pu + (size_t)(16 * (t0 + 1)) * INC;
            aUn = quad < 2 ? *(const bf16x8*)(pn + (size_t)l15 * INC + quad * 8) : zero8;
            if (OUT) {
#pragma unroll
                for (int r = 0; r < 4; ++r) uvn[r] = pn[(size_t)(quad * 4 + r) * INC + l15]; }
        }
#pragma unroll
        for (int t = 0; t < 8; ++t) { const f32x4 c = MFMA16(aU, bB[t], ((f32x4){0.f, 0.f, 0.f, 0.f}));
#pragma unroll
            for (int r = 0; r < 4; ++r) bu[(quad * 4 + r) * 132 + 16 * t + l15] = c[r]; }
        __syncthreads();
#pragma unroll
        for (int t = 0; t < 16; ++t) { const float re = bu[t * 132 + lane], im = bu[t * 132 + 64 + lane];
            const float nr = lam_r * xr - lam_i * xi + re, ni = lam_r * xi + lam_i * xr + im; xr = nr; xi = ni;
            if (OUT) { xs[t * 136 + lane] = f2bf(xr); xs[t * 136 + 64 + lane] = f2bf(xi); } }
        __syncthreads();
        if (OUT) {
            f32x4 y = {0.f, 0.f, 0.f, 0.f};
#pragma unroll
            for (int kk = 0; kk < 4; ++kk) { const bf16x8 aX = *(const LAS bf16x8*)(xs + l15 * 136 + 32 * kk + quad * 8); y = MFMA16(aX, bC[kk], y); }
#pragma unroll
            for (int r = 0; r < 4; ++r) { const size_t row = rowb + quad * 4 + r;
                const float uv = bf2f(uvc[r]);
                const float v = y[r] + dsk * uv;
                const float a = 0.7978845608028654f * (v + 0.044715f * v * v * v);
                const float th = 1.0f - 2.0f * __builtin_amdgcn_rcpf(1.0f + __expf(2.0f * a));
                ys[row * DH + g * 16 + l15] = f2bf(0.5f * v * (1.0f + th)); }
            __syncthreads();
        }
    }
}

DI void run_phase(const Ctx cx, const Params& p, int ph, LAS unsigned char* lds) {
    const int l = ph / NPH_LAYER, k = ph % NPH_LAYER;
    const int tid = cx.tid, w = tid >> 6, lane = tid & 63, bid = cx.bid, nb = cx.nb;
    float* xres = p.out + O_Y;
    pg8::StaticOrder S;
    const float* part = (const float*)(p.ws + WS_PART);
    if (ph == 2 * NPH_LAYER) { phase_rmsnorm<false, true>(cx, xres, xres + (size_t)TP * DM, p.in[25], nullptr, xres, part, xres, xres + (size_t)TP * DM, xres, lds); return; }
    switch (k) {
    case 0: {
        phase_convert(cx, p, l, lds);
        const float* xa = l == 0 ? p.in[0] : xres; const float* xb = l == 0 ? p.in[1] : xres + (size_t)TP * DM;
        if (l == 0) phase_rmsnorm<true, false>(cx, xa, xb, p.in[6], (bf16_t*)(p.ws + WS_HB), nullptr, nullptr, nullptr, nullptr, nullptr, lds);
        else phase_rmsnorm<true, true>(cx, xa, xb, p.in[6] + DM, (bf16_t*)(p.ws + WS_HB), nullptr, part, xa, xb, xres, lds);
    } break;
    case 1: {
        S.init(T, INC, DM, nb, bid, 0);
        pg8::gemm_phase(cx, lds, pg8::Gemm{(const bf16_t*)(p.ws + WS_HB), (const bf16_t*)(p.ws + WS_WIN), T, INC, DM}, S, EpiInproj{(bf16_t*)(p.ws + WS_P), (float*)(p.ws + WS_FZ)});
    } break;
    case 2: {
        float* seg = (float*)(p.ws + WS_SEG); float* dseg = (float*)(p.ws + WS_DSEG);
        for (int it = bid; it < NHSEG * 8; it += nb) { const int sg = it >> 3, h = it & 7;
            hgrn_item<false>(cx, p, l, h, sg * HSEG, HSEG / 64, 4, nullptr, seg + (size_t)it * 16384, dseg + it * 128, lds); }
        __syncthreads();
        float* E = (float*)(p.ws + WS_S5E);
        for (int tk = bid * 8 + w; tk < (NSSEG - 1) * 64; tk += nb * 8) { const int sg = tk >> 6, g = tk & 63;
            float xr = 0.f, xi = 0.f; s5_task<false>(cx, p, l, g, sg * SSEG, SSEG / 16, xr, xi, lds + w * 12800);
            E[(size_t)tk * 128 + lane] = xr; E[(size_t)tk * 128 + 64 + lane] = xi; }
    } break;
    case 3: {
        float* seg = (float*)(p.ws + WS_SEG); const float* dseg = (const float*)(p.ws + WS_DSEG);
        for (int e = bid * 512 + tid; e < 8 * 16384; e += nb * 512) { const int h = e >> 14, rem = e & 16383, dk = rem >> 7;
            float Sv = 0.f; float Lv[NHSEG], Dv[NHSEG];
#pragma unroll
            for (int sg = 0; sg < NHSEG; ++sg) { Lv[sg] = seg[(size_t)(sg * 8 + h) * 16384 + rem]; Dv[sg] = dseg[(sg * 8 + h) * 128 + dk]; }
#pragma unroll
            for (int sg = 0; sg < NHSEG; ++sg) { seg[(size_t)(sg * 8 + h) * 16384 + rem] = Sv; Sv = Dv[sg] * Sv + Lv[sg]; }
            p.out[O_HP + (size_t)l * 131072 + e] = Sv; }
    } break;
    case 4: {
        float* seg = (float*)(p.ws + WS_SEG);
#ifndef HREP
#define HREP 1
#endif
#ifndef SREP
#define SREP 1
#endif
        for (int rep = 0; rep < HREP; ++rep)
        for (int it = bid; it < NHSEG * 8 + 32 * 8; it += nb) {
            const bool pr = it < NHSEG * 8; const int i2 = pr ? it : it - NHSEG * 8; const int a = i2 >> 3, h = i2 & 7;
            const size_t so = ((size_t)(l * 32 + a) * 8 + h) * 16384;
            const float* sin_ = pr ? seg + (size_t)it * 16384 : p.in[2] + so; float* sout_ = pr ? nullptr : p.out + O_HS + so;
            hgrn_item<true>(cx, p, l, h, pr ? a * HSEG : TP + a * 32, pr ? HSEG / 64 : 1, pr ? 4 : 2, sin_, sout_, nullptr, lds); }
        __syncthreads();
        const float* E = (const float*)(p.ws + WS_S5E); const float* laml = (const float*)(p.ws + WS_LAML);
        for (int rep = 0; rep < SREP; ++rep)
        for (int tk = bid * 8 + w; tk < NSSEG * 64 + 32 * 64; tk += nb * 8) {
            const bool pr = tk < NSSEG * 64; const int t2 = pr ? tk : tk - NSSEG * 64; const int a = t2 >> 6, g = t2 & 63;
            const size_t so = ((size_t)(l * 32 + a) * 64 + g) * 64 + lane;
            float xr = 0.f, xi = 0.f;
            if (pr) { const float Lr = laml[g * 128 + lane], Li = laml[g * 128 + 64 + lane];
                int j = 0;
                for (; j + 8 <= a; j += 8) { float er[8], ei[8];
#pragma unroll
                    for (int q = 0; q < 8; ++q) { er[q] = E[(size_t)((j + q) * 64 + g) * 128 + lane]; ei[q] = E[(size_t)((j + q) * 64 + g) * 128 + 64 + lane]; }
#pragma unroll
                    for (int q = 0; q < 8; ++q) { const float nr = Lr * xr - Li * xi + er[q], ni = Lr * xi + Li * xr + ei[q]; xr = nr; xi = ni; } }
                for (; j < a; ++j) { const float er = E[(size_t)(j * 64 + g) * 128 + lane], ei = E[(size_t)(j * 64 + g) * 128 + 64 + lane];
                    const float nr = Lr * xr - Li * xi + er, ni = Lr * xi + Li * xr + ei; xr = nr; xi = ni; } }
            else { xr = p.in[3][so]; xi = p.in[4][so]; }
            s5_task<true>(cx, p, l, g, pr ? a * SSEG : TP + a * 32, pr ? SSEG / 16 : 2, xr, xi, lds + w * 12800);
            if (!pr) { p.out[O_SRS + so] = xr; p.out[O_SIS + so] = xi; }
            else if (a == NSSEG - 1) { p.out[O_SRP + (size_t)l * 4096 + g * 64 + lane] = xr; p.out[O_SIP + (size_t)l * 4096 + g * 64 + lane] = xi; }
        }
    } break;
    case 5: {
        S.init(T, DH, DH, nb, bid, 0);
        pg8::gemm_phase(cx, lds, pg8::Gemm{(const bf16_t*)(p.ws + WS_YS), (const bf16_t*)(p.ws + WS_WGLU), T, DH, DH}, S, EpiGlu{(const bf16_t*)(p.ws + WS_YS), (bf16_t*)(p.ws + WS_OS), p.in[19] + l * DH});
        S.init(T, DM, DH, nb, (bid + 128) % nb, 0);
        pg8::gemm_phase(cx, lds, pg8::Gemm{(const bf16_t*)(p.ws + WS_OH), (const bf16_t*)(p.ws + WS_WBH), T, DM, DH}, S, EpiMix<false>{(const bf16_t*)(p.ws + WS_P), C_GH, (bf16_t*)(p.ws + WS_MIX)});
    } break;
    case 6: {
        S.init(T, DM, DH, nb, bid, 0);
        pg8::gemm_phase(cx, lds, pg8::Gemm{(const bf16_t*)(p.ws + WS_OS), (const bf16_t*)(p.ws + WS_WBS), T, DM, DH}, S, EpiMix<true>{(const bf16_t*)(p.ws + WS_P), C_GS, (bf16_t*)(p.ws + WS_MIX)});
    } break;
    case 7: {
        S.init(T, DM, DM, nb, bid, nb == 256 ? 8 : 0);
        const float* xa = l == 0 ? p.in[0] : xres; const float* xb = l == 0 ? p.in[1] : xres + (size_t)TP * DM;
        pg8::gemm_phase(cx, lds, pg8::Gemm{(const bf16_t*)(p.ws + WS_MIX), (const bf16_t*)(p.ws + WS_WOUT), T, DM, DM}, S, EpiResid{xa, xb, xres, (float*)(p.ws + WS_PART)});
    } break;
    case 8: {
        phase_rmsnorm<true, true>(cx, xres, xres + (size_t)TP * DM, p.in[22] + l * DM, (bf16_t*)(p.ws + WS_HB), nullptr, part, l == 0 ? p.in[0] : xres, l == 0 ? p.in[1] : xres + (size_t)TP * DM, xres, lds);
    } break;
    case 9: {
        S.init(T, 2 * DFF, DM, nb, bid, 0);
        pg8::gemm_phase(cx, lds, pg8::Gemm{(const bf16_t*)(p.ws + WS_HB), (const bf16_t*)(p.ws + WS_WGU), T, 2 * DFF, DM}, S, EpiSwiglu{(bf16_t*)(p.ws + WS_HID)});
    } break;
    case 10: {
        S.init(T, DM, DFF, nb, bid, nb == 256 ? 8 : 0);
        pg8::gemm_phase(cx, lds, pg8::Gemm{(const bf16_t*)(p.ws + WS_HID), (const bf16_t*)(p.ws + WS_WDN), T, DM, DFF}, S, EpiResid{xres, xres + (size_t)TP * DM, xres, (float*)(p.ws + WS_PART)});
    } break;
    }
}

DI void grid_seam(const Ctx cx, unsigned* bar, int bi) {
    asm volatile("s_waitcnt vmcnt(0) lgkmcnt(0)" ::: "memory");
    __syncthreads();
    if (cx.tid == 0) { __builtin_amdgcn_fence(__ATOMIC_RELEASE, "agent"); asm volatile("s_waitcnt vmcnt(0)" ::: "memory"); }
    if (bi < 0) cg::this_grid().sync();
    if (cx.tid == 0) {
        __hip_atomic_fetch_add(bar, 1u, __ATOMIC_RELAXED, __HIP_MEMORY_SCOPE_AGENT);
        const unsigned target = (unsigned)(bi + 1) * (unsigned)cx.nb;
        while (__hip_atomic_load(bar, __ATOMIC_RELAXED, __HIP_MEMORY_SCOPE_AGENT) < target) __builtin_amdgcn_s_sleep(1);
        __builtin_amdgcn_fence(__ATOMIC_ACQUIRE, "agent"); asm volatile("s_waitcnt vmcnt(0)" ::: "memory");
    }
    __syncthreads();
}

__global__ __launch_bounds__(512, 2) void mega_fwd(Params p, int ph_lo, int ph_hi) {
    extern __shared__ __attribute__((aligned(16))) unsigned char shm[];
    LAS unsigned char* lds = (LAS unsigned char*)shm;
    for (int ph = ph_lo; ph < ph_hi; ++ph) {
        Ctx cx; cx.tid = threadIdx.x; cx.bid = blockIdx.x; cx.nb = gridDim.x;
        asm volatile("" : "+v"(cx.tid)); asm volatile("" : "+s"(cx.bid), "+s"(cx.nb));
        run_phase(cx, p, ph, lds);
        if (ph + 1 < ph_hi) grid_seam(cx, (unsigned*)(p.ws + WS_BAR), ph - ph_lo);
    }
}

extern "C" void kernel_launch(void* const* d_in, const int* in_sizes, int n_in, void* d_out, int out_size, void* d_ws, size_t ws_size, hipStream_t stream) {
    static int grid_blocks = 0;
    if (grid_blocks == 0) {
        if (n_in != 26 || ws_size < WS_END) { fprintf(stderr, "kernel_launch: unexpected n_in %d / ws_size %zu (need %zu)\n", n_in, ws_size, (size_t)WS_END); grid_blocks = -1; return; }
        int dev = 0, cus = 0, per_cu = 0;
        hipGetDevice(&dev);
        hipDeviceGetAttribute(&cus, hipDeviceAttributeMultiprocessorCount, dev);
        if (hipFuncSetAttribute((const void*)mega_fwd, hipFuncAttributeMaxDynamicSharedMemorySize, LDS_BYTES) != hipSuccess) { fprintf(stderr, "kernel_launch: hipFuncSetAttribute failed\n"); grid_blocks = -1; return; }
        if (hipOccupancyMaxActiveBlocksPerMultiprocessor(&per_cu, (const void*)mega_fwd, 512, LDS_BYTES) != hipSuccess || per_cu < 1) { fprintf(stderr, "kernel_launch: occupancy query gave %d\n", per_cu); per_cu = 1; (void)hipGetLastError(); }
        grid_blocks = cus * per_cu;
    }
    if (grid_blocks < 0) return;
    Params p{};
    for (int i = 0; i < 26; ++i) p.in[i] = (const float*)d_in[i];
    p.out = (float*)d_out; p.ws = (unsigned char*)d_ws;
#if COOP
    if (hipMemsetAsync((char*)d_ws + WS_BAR, 0, 4096, stream) != hipSuccess) { fprintf(stderr, "kernel_launch: memset of the barrier words failed\n"); return; }
    int lo = 0, hi = NPHASES;
    void* args[] = {&p, &lo, &hi};
    hipError_t e = hipLaunchCooperativeKernel((const void*)mega_fwd, dim3(grid_blocks), dim3(512), args, LDS_BYTES, stream);
    if (e != hipSuccess) fprintf(stderr, "cooperative launch failed: %s (grid %d)\n", hipGetErrorString(e), grid_blocks);
#else
    for (int ph = 0; ph < NPHASES; ++ph) hipLaunchKernelGGL(mega_fwd, dim3(grid_blocks), dim3(512), LDS_BYTES, stream, p, ph, ph + 1);
#endif
}
```
